# Optimizing an MI355X kernel written in HIP

```python
import math
import jax, jax.numpy as jnp
from jax import lax
import numpy as np

D_MODEL = 1024
BATCH = 8
SEQ = 4096
DEPTH = 1
DEC_BATCH = 128
DEC_SEQ = 8
PAST_LEN = 16384
PAGE_SIZE = 128

N_META = 16
HEAD_DIM = 64
ATTN_WIDTH = D_MODEL // 2
N_Q_HEADS = ATTN_WIDTH // HEAD_DIM
Q_PER_KV = 4
N_KV_HEADS = N_Q_HEADS // Q_PER_KV
KV_WIDTH = N_KV_HEADS * HEAD_DIM
WINDOW = 128
BLOCK = 128
SSM_WIDTH = D_MODEL - ATTN_WIDTH
SSM_GROUP = 16
N_SSM_GROUPS = SSM_WIDTH // SSM_GROUP
SSM_STATE = 64
IN_COLS = ATTN_WIDTH + 2 * KV_WIDTH + SSM_WIDTH
D_FF = -(-8 * D_MODEL // (3 * 256)) * 256
EPS = 1e-6
ATTN_SCALE = HEAD_DIM ** -0.5

kernel_name = "hymba_s5_swa_sink_decoder_step"


def rms_norm(x, g):
    xf = x.astype(jnp.float32)
    y = xf * lax.rsqrt(jnp.mean(xf * xf, axis=-1, keepdims=True) + EPS)
    return (y * g.astype(jnp.float32)).astype(x.dtype)


def mixer_front(x, g_mix, w_in, g_q, g_k):
    b, l = x.shape[:2]
    z = rms_norm(x, g_mix) @ w_in
    q, k, v, u = jnp.split(z, [ATTN_WIDTH, ATTN_WIDTH + KV_WIDTH, ATTN_WIDTH + 2 * KV_WIDTH], axis=-1)
    q = rms_norm(q.reshape(b, l, N_Q_HEADS, HEAD_DIM), g_q)
    k = rms_norm(k.reshape(b, l, N_KV_HEADS, HEAD_DIM), g_k)
    v = v.reshape(b, l, N_KV_HEADS, HEAD_DIM)
    u = u.reshape(b, l, N_SSM_GROUPS, SSM_GROUP)
    return q, k, v, u


def sink_attention(q, k, v, mask, sinks):
    lead = q.shape[:-3]
    tq = q.shape[-3]
    qg = q.reshape(lead + (tq, N_KV_HEADS, Q_PER_KV, HEAD_DIM))
    s = jnp.einsum('...qhgd,...khd->...hgqk', qg, k).astype(jnp.float32) * ATTN_SCALE
    s = jnp.where(mask, s, -jnp.inf)
    sink = sinks.astype(jnp.float32).reshape(N_KV_HEADS, Q_PER_KV, 1, 1)
    m = jnp.maximum(jnp.max(s, axis=-1, keepdims=True), sink)
    p = jnp.exp(s - m)
    p = p / (jnp.sum(p, axis=-1, keepdims=True) + jnp.exp(sink - m))
    o = jnp.einsum('...hgqk,...khd->...qhgd', p.astype(v.dtype), v)
    return o.reshape(lead + (tq, N_Q_HEADS * HEAD_DIM))


def prompt_window_attention(q, k, v, sinks):
    b, l = q.shape[:2]
    lpad = (-N_META) % BLOCK
    rpad = (-(lpad + l)) % BLOCK
    padw = ((0, 0), (lpad, rpad), (0, 0), (0, 0))
    qp, kp, vp = jnp.pad(q, padw), jnp.pad(k, padw), jnp.pad(v, padw)
    lp = lpad + l + rpad
    nb = lp // BLOCK
    qb = qp.reshape(b, nb, BLOCK, N_Q_HEADS, HEAD_DIM)
    kb = kp.reshape(b, nb, BLOCK, N_KV_HEADS, HEAD_DIM)
    vb = vp.reshape(b, nb, BLOCK, N_KV_HEADS, HEAD_DIM)

    def prev(t):
        return jnp.pad(t, ((0, 0), (1, 0), (0, 0), (0, 0), (0, 0)))[:, :-1]

    kk = jnp.concatenate([prev(kb), kb], axis=2)
    vv = jnp.concatenate([prev(vb), vb], axis=2)
    qpos = jnp.arange(nb)[:, None] * BLOCK + jnp.arange(BLOCK)[None, :]
    kpos = jnp.arange(nb)[:, None] * BLOCK - BLOCK + jnp.arange(2 * BLOCK)[None, :]
    dist = qpos[:, :, None] - kpos[:, None, :]
    valid_k = (kpos >= lpad) & (kpos < lpad + l)
    mask = (dist >= 0) & (dist <= WINDOW) & valid_k[:, None, :]
    o = sink_attention(qb, kk, vv, mask[None, :, None, None], sinks)
    return o.reshape(b, lp, ATTN_WIDTH)[:, lpad:lpad + l]


def sample_window_attention(q, k, v, cache_k, cache_v, sinks):
    t = q.shape[1]
    kk = jnp.concatenate([cache_k.astype(k.dtype), k], axis=1)
    vv = jnp.concatenate([cache_v.astype(v.dtype), v], axis=1)
    dist = (jnp.arange(t)[:, None] + WINDOW) - jnp.arange(WINDOW + t)[None, :]
    mask = (dist >= 0) & (dist <= WINDOW)
    o = sink_attention(q, kk, vv, mask[None, None, None], sinks)
    return o, kk[:, t:], vv[:, t:]


def zoh_discretize(a_re, a_im, log_dt, b_re, b_im):
    f32 = jnp.float32
    ar, ai = a_re.astype(f32), a_im.astype(f32)
    dt = jnp.exp(log_dt.astype(f32))[:, None]
    mag = jnp.exp(ar * dt)
    lr, li = mag * jnp.cos(ai * dt), mag * jnp.sin(ai * dt)
    nr, ni = lr - 1.0, li
    den = ar * ar + ai * ai
    fr, fi = (nr * ar + ni * ai) / den, (ni * ar - nr * ai) / den
    br, bi = b_re.astype(f32), b_im.astype(f32)
    bbr = fr[..., None] * br - fi[..., None] * bi
    bbi = fr[..., None] * bi + fi[..., None] * br
    return lr, li, bbr, bbi


def _ssm_combine(e1, e2):
    a1r, a1i, b1r, b1i = e1
    a2r, a2i, b2r, b2i = e2
    return (a2r * a1r - a2i * a1i, a2r * a1i + a2i * a1r,
            a2r * b1r - a2i * b1i + b2r, a2r * b1i + a2i * b1r + b2i)


def ssm_mixer(u, h0_re, h0_im, a_re, a_im, log_dt, b_re, b_im, c_re, c_im, d_skip, w_glu, b_glu):
    f32 = jnp.float32
    b, l = u.shape[:2]
    lr, li, bbr, bbi = zoh_discretize(a_re, a_im, log_dt, b_re, b_im)
    uf = u.astype(f32)
    xr = jnp.einsum('blgh,gph->blgp', uf, bbr)
    xi = jnp.einsum('blgh,gph->blgp', uf, bbi)
    h0r, h0i = h0_re.astype(f32), h0_im.astype(f32)
    xr = xr.at[:, 0].add(lr * h0r - li * h0i)
    xi = xi.at[:, 0].add(lr * h0i + li * h0r)
    ar = jnp.broadcast_to(lr, (1, l) + lr.shape)
    ai = jnp.broadcast_to(li, (1, l) + li.shape)
    _, _, hr, hi = lax.associative_scan(_ssm_combine, (ar, ai, xr, xi), axis=1)
    y = (jnp.einsum('blgp,ghp->blgh', hr, c_re.astype(f32))
         - jnp.einsum('blgp,ghp->blgh', hi, c_im.astype(f32))
         + d_skip.astype(f32) * uf)
    g = jax.nn.gelu(y)
    gate = jnp.einsum('blgh,ghk->blgk', g, w_glu.astype(f32)) + b_glu.astype(f32)
    out = (g * jax.nn.sigmoid(gate)).reshape(b, l, SSM_WIDTH).astype(u.dtype)
    return out, hr[:, -1], hi[:, -1]


def mixer_back(x, o_att, o_ssm, g_att_out, g_ssm_out, w_out, g_ffn, w_gate, w_up, w_down):
    mix = jnp.concatenate([rms_norm(o_att, g_att_out), rms_norm(o_ssm.astype(o_att.dtype), g_ssm_out)], axis=-1)
    h = x + mix @ w_out
    f = rms_norm(h, g_ffn)
    return h + (jax.nn.silu(f @ w_gate) * (f @ w_up)) @ w_down


def setup_inputs(seed: int = 0) -> dict:
    key = jax.random.key(seed)
    ks = jax.random.split(key, 32)
    f32 = jnp.float32
    G, P, H = N_SSM_GROUPS, SSM_STATE, SSM_GROUP

    def nrm(k, shape, scale=1.0):
        return scale * jax.random.normal(k, shape, f32)

    def gain(k, shape):
        return 1.0 + 0.02 * jax.random.normal(k, shape, f32)

    n_idx = jnp.arange(P, dtype=f32)
    return {
        "x_prompt": nrm(ks[0], (BATCH, SEQ, D_MODEL)),
        "x_sample": nrm(ks[1], (DEC_BATCH, DEC_SEQ, D_MODEL)),
        "cache_k_win": nrm(ks[2], (DEPTH, DEC_BATCH, WINDOW, N_KV_HEADS, HEAD_DIM)),
        "cache_v_win": nrm(ks[3], (DEPTH, DEC_BATCH, WINDOW, N_KV_HEADS, HEAD_DIM)),
        "state_ssm_re": nrm(ks[4], (DEPTH, DEC_BATCH, G, P), 0.1),
        "state_ssm_im": nrm(ks[5], (DEPTH, DEC_BATCH, G, P), 0.1),
        "meta_tokens": nrm(ks[6], (N_META, D_MODEL)),
        "g_mix": gain(ks[7], (DEPTH, D_MODEL)),
        "w_in": nrm(ks[8], (DEPTH, D_MODEL, IN_COLS), D_MODEL ** -0.5),
        "g_q": gain(ks[9], (DEPTH, HEAD_DIM)),
        "g_k": gain(ks[10], (DEPTH, HEAD_DIM)),
        "sinks": nrm(ks[11], (DEPTH, N_Q_HEADS), 0.5),
        "ssm_a_re": -0.5 + nrm(ks[12], (DEPTH, G, P), 0.01),
        "ssm_a_im": math.pi * n_idx + nrm(ks[13], (DEPTH, G, P), 0.01),
        "ssm_log_dt": jax.random.uniform(ks[14], (DEPTH, G), f32, math.log(1e-3), math.log(1e-1)),
        "ssm_b_re": nrm(ks[15], (DEPTH, G, P, H), (2 * H) ** -0.5),
        "ssm_b_im": nrm(ks[16], (DEPTH, G, P, H), (2 * H) ** -0.5),
        "ssm_c_re": nrm(ks[17], (DEPTH, G, H, P), P ** -0.5),
        "ssm_c_im": nrm(ks[18], (DEPTH, G, H, P), P ** -0.5),
        "ssm_d": nrm(ks[19], (DEPTH, G, H)),
        "ssm_w_glu": nrm(ks[20], (DEPTH, G, H, H), H ** -0.5),
        "ssm_b_glu": nrm(ks[21], (DEPTH, G, H), 0.01),
        "g_att_out": gain(ks[22], (DEPTH, ATTN_WIDTH)),
        "g_ssm_out": gain(ks[23], (DEPTH, SSM_WIDTH)),
        "w_out": nrm(ks[24], (DEPTH, D_MODEL, D_MODEL), D_MODEL ** -0.5),
        "g_ffn": gain(ks[25], (DEPTH, D_MODEL)),
        "w_gate": nrm(ks[26], (DEPTH, D_MODEL, D_FF), D_MODEL ** -0.5),
        "w_up": nrm(ks[27], (DEPTH, D_MODEL, D_FF), D_MODEL ** -0.5),
        "w_down": nrm(ks[28], (DEPTH, D_FF, D_MODEL), D_FF ** -0.5),
    }


def reference(x_prompt, x_sample, cache_k_win, cache_v_win, state_ssm_re, state_ssm_im,
              meta_tokens, g_mix, w_in, g_q, g_k, sinks,
              ssm_a_re, ssm_a_im, ssm_log_dt, ssm_b_re, ssm_b_im, ssm_c_re, ssm_c_im,
              ssm_d, ssm_w_glu, ssm_b_glu, g_att_out, g_ssm_out, w_out,
              g_ffn, w_gate, w_up, w_down):
    bp = x_prompt.shape[0]
    meta = jnp.broadcast_to(meta_tokens.astype(x_prompt.dtype), (bp, N_META, D_MODEL))
    xp = jnp.concatenate([meta, x_prompt], axis=1)
    xs = x_sample
    kp_l, vp_l, rp_l, ip_l = [], [], [], []
    ks_l, vs_l, rs_l, is_l = [], [], [], []
    for li in range(DEPTH):
        ssm_p = (ssm_a_re[li], ssm_a_im[li], ssm_log_dt[li], ssm_b_re[li], ssm_b_im[li],
                 ssm_c_re[li], ssm_c_im[li], ssm_d[li], ssm_w_glu[li], ssm_b_glu[li])
        back_p = (g_att_out[li], g_ssm_out[li], w_out[li], g_ffn[li], w_gate[li], w_up[li], w_down[li])

        q, k, v, u = mixer_front(xp, g_mix[li], w_in[li], g_q[li], g_k[li])
        o_att = prompt_window_attention(q, k, v, sinks[li])
        h0 = jnp.zeros((bp, N_SSM_GROUPS, SSM_STATE), jnp.float32)
        o_ssm, hr, hi = ssm_mixer(u, h0, h0, *ssm_p)
        xp = mixer_back(xp, o_att, o_ssm, *back_p)
        kp_l.append(k[:, -WINDOW:])
        vp_l.append(v[:, -WINDOW:])
        rp_l.append(hr)
        ip_l.append(hi)

        q, k, v, u = mixer_front(xs, g_mix[li], w_in[li], g_q[li], g_k[li])
        o_att, nk, nv = sample_window_attention(q, k, v, cache_k_win[li], cache_v_win[li], sinks[li])
        o_ssm, hr, hi = ssm_mixer(u, state_ssm_re[li], state_ssm_im[li], *ssm_p)
        xs = mixer_back(xs, o_att, o_ssm, *back_p)
        ks_l.append(nk)
        vs_l.append(nv)
        rs_l.append(hr)
        is_l.append(hi)

    y_prompt = xp[:, N_META:]
    y_sample = xs
    return (y_prompt, y_sample,
            jnp.stack(kp_l), jnp.stack(vp_l), jnp.stack(rp_l), jnp.stack(ip_l),
            jnp.stack(ks_l), jnp.stack(vs_l), jnp.stack(rs_l), jnp.stack(is_l))
```

```cpp
#include <hip/hip_runtime.h>
#include <cstdio>
#include <cstdint>
#include <cmath>

#ifndef MK_N_LAUNCHES
#define MK_N_LAUNCHES 1
#endif

constexpr int DM = 1024, NBATCH = 8, SEQ = 4096, NMETA = 16, DECB = 128, DECS = 8;
constexpr int NROW_P = NBATCH * SEQ;
constexpr int NROW_S = DECB * DECS;
constexpr int NROW = NROW_P + NROW_S;
constexpr int ROW_META = NROW;
constexpr int NROW_IN = 34048;
constexpr int INC = 1280, DFF = 2816, NGU = 2 * DFF;
constexpr int KVS = 4224;
constexpr int NHQ = 8, NKV = 2, HD = 64, NG = 32, GH = 16, NP = 64, WIN = 128;
constexpr float EPS = 1e-6f;
constexpr float LOG2E = 1.4426950408889634f;
constexpr float QSCALE = 0.125f * LOG2E;

constexpr size_t O_Y = 0;
constexpr size_t O_KWP = (size_t)NROW * DM;
constexpr size_t O_VWP = O_KWP + 131072;
constexpr size_t O_SRP = O_VWP + 131072;
constexpr size_t O_SIP = O_SRP + 16384;
constexpr size_t O_KWS = O_SIP + 16384;
constexpr size_t O_VWS = O_KWS + 2097152;
constexpr size_t O_SRS = O_VWS + 2097152;
constexpr size_t O_SIS = O_SRS + 262144;
constexpr size_t O_END = O_SIS + 262144;

constexpr size_t MiB = 1u << 20;
constexpr size_t WS_CTL = 0, CTL_ZERO_BYTES = 1 * MiB;
constexpr size_t WS_WIN = 2 * MiB;
constexpr size_t WS_WO = 5 * MiB;
constexpr size_t WS_WGU = 7 * MiB;
constexpr size_t WS_WD = 18 * MiB;
constexpr size_t WS_SSMC = 24 * MiB;
constexpr size_t WS_SSQ = 28 * MiB;
constexpr size_t WS_KS = 29 * MiB;
constexpr size_t WS_VS = WS_KS + 512 * 1024;
constexpr size_t WS_US = 30 * MiB;
constexpr size_t WS_MIX = 32 * MiB;
constexpr size_t WS_HB = 98 * MiB;
constexpr size_t WS_HFF = 164 * MiB;
constexpr size_t WS_XN = 164 * MiB;
constexpr size_t WS_Q = 231 * MiB;
constexpr size_t WS_KP = 265 * MiB;
constexpr size_t WS_VP = 274 * MiB;
constexpr size_t WS_U = 283 * MiB;
constexpr size_t WS_END = 346 * MiB;
static_assert(WS_XN + (size_t)NROW_IN * DM * 2 <= WS_Q && WS_Q + (size_t)NROW_IN * 512 * 2 <= WS_KP && WS_KP + (size_t)NBATCH * KVS * 128 * 2 <= WS_VP &&
              WS_VP + (size_t)NBATCH * KVS * 128 * 2 <= WS_U && WS_U + (size_t)NG * NBATCH * KVS * 16 * 2 <= WS_END && WS_HFF + (size_t)NROW * DFF * 2 <= WS_END &&
              WS_MIX + (size_t)NROW * DM * 2 <= WS_HB && WS_HB + (size_t)NROW * DM * 2 <= WS_HFF && WS_WD + (size_t)DM * DFF * 2 <= WS_SSMC, "d_ws map");

constexpr int RING_OFF = 0, RING_BYTES = 131072;
constexpr int LDSCTL_OFF = RING_BYTES, MISC_OFF = LDSCTL_OFF + 320;
constexpr int LDS_BYTES = 147456;
constexpr int NWAVES = 8;

#define GAS __attribute__((address_space(1)))
#define LAS __attribute__((address_space(3)))
typedef unsigned short bf16;
typedef unsigned v4u __attribute__((ext_vector_type(4)));
typedef unsigned v2u __attribute__((ext_vector_type(2)));
typedef float v4f __attribute__((ext_vector_type(4)));
typedef GAS unsigned gu32;
#define RLX_AGENT __ATOMIC_RELAXED, __HIP_MEMORY_SCOPE_AGENT
#define LDS_WAIT() asm volatile("s_waitcnt lgkmcnt(0)" ::: "memory")
#define VM_WAIT() asm volatile("s_waitcnt vmcnt(0)" ::: "memory")
__device__ __forceinline__ unsigned f2bf(float f) { unsigned u = __builtin_bit_cast(unsigned, f); return (u + 0x7fffu + ((u >> 16) & 1u)) >> 16; }
__device__ __forceinline__ unsigned pk2(float lo, float hi) { return f2bf(lo) | (f2bf(hi) << 16); }
__device__ __forceinline__ float bflo(unsigned w) { return __builtin_bit_cast(float, w << 16); }
__device__ __forceinline__ float bfhi(unsigned w) { return __builtin_bit_cast(float, w & 0xffff0000u); }
__device__ __forceinline__ float bf2f(bf16 b) { return __builtin_bit_cast(float, (unsigned)b << 16); }
__device__ __forceinline__ float wave_sum(float v) {
#pragma unroll
    for (int o = 1; o < 64; o <<= 1) v += __shfl_xor(v, o);
    return v;
}
__device__ __forceinline__ float wave_max(float v) {
#pragma unroll
    for (int o = 1; o < 64; o <<= 1) v = fmaxf(v, __shfl_xor(v, o));
    return v;
}
__device__ __forceinline__ float gelu_tanh(float x) {
    const float z = 0.7978845608028654f * (x + 0.044715f * x * x * x);
    return x / (1.0f + __builtin_amdgcn_exp2f(-2.0f * LOG2E * z));
}
__device__ __forceinline__ float sigmoidf_(float x) { return 1.0f / (1.0f + __builtin_amdgcn_exp2f(-LOG2E * x)); }

namespace pg8 {
#define PG8_LAS __attribute__((address_space(3)))
typedef unsigned short bf16_t;
typedef short bf16x8 __attribute__((ext_vector_type(8)));
typedef float f32x4 __attribute__((ext_vector_type(4)));
typedef unsigned u32x4 __attribute__((ext_vector_type(4)));
constexpr int BM = 256, BK = 64, HALF = 128, HTB = HALF * BK * 2  , STAGE_BYTES = 8 * HTB, NXCD = 8, WGM = 8;

__host__ __device__ __forceinline__ int lds_byte(int r, int c) { const int st = (r >> 4) * 2 + (c >> 5), rr = r & 15, cc = c & 31, ob = rr * 64 + cc * 2; return st * 1024 + (ob ^ (((ob >> 9) & 1) << 5)); }
__host__ __device__ __forceinline__ void stage_rc(int b, int& R, int& C) { const int st = b / 1024, sb = b % 1024, swz = sb ^ (((sb >> 9) & 1) << 5); R = (st >> 1) * 16 + swz / 64; C = (st & 1) * 32 + (swz % 64) / 2; }
__host__ __device__ __forceinline__ int perm32(int rho) { const int n = rho >> 4, i = rho & 15; return 8 * (i >> 2) + 4 * n + (i & 3); }

struct Unit { int pm, pn; };
struct Gemm { const bf16_t* A; const bf16_t* Bt; int M, N, K; };

struct StaticOrder {
    int nM, nN, nwg, G, c;
    __host__ __device__ void init(int M, int N, int G_, int c_) { nM = M / BM; nN = N / BM; nwg = nM * nN; G = G_; c = c_; }
    __host__ __device__ bool next(int i, Unit& u) const {
        const long L = (long)i * G + c; if (L >= nwg) return false;
        int wgid = (int)L; { const int q = nwg / NXCD, r = nwg % NXCD, xcd = wgid % NXCD, off = wgid / NXCD; wgid = (xcd < r ? xcd * (q + 1) : r * (q + 1) + (xcd - r) * q) + off; }
        const int nig = WGM * nN, gid = wgid / nig, fm = gid * WGM, gsz = (nM - fm) < WGM ? (nM - fm) : WGM;
        u.pm = fm + ((wgid % nig) % gsz); u.pn = (wgid % nig) / gsz; return true;
    }
    __device__ __forceinline__ void a_ready(const Unit&) const {}
    __device__ __forceinline__ void done(const Unit&) const {}
};

__device__ __forceinline__ unsigned cvt_pk_bf16(float lo, float hi) { unsigned r; asm volatile("v_cvt_pk_bf16_f32 %0, %1, %2" : "=v"(r) : "v"(lo), "v"(hi)); return r; }

typedef unsigned u32x2 __attribute__((ext_vector_type(2)));
constexpr int E_NROW_P = 32768, E_NROW = 33792, E_KVS = 4224;
constexpr float E_EPS = 1e-6f, E_QSCALE = 0.125f * 1.4426950408889634f;

struct EpiInProj {
    static constexpr bool PERM = true, AFTER_DRAIN = false, MIDSCALE = false;
    bf16_t *Q, *Kp, *Vp, *Ks, *Vs, *U, *Us; const float *gq, *gk;
    __device__ __forceinline__ void mid(f32x4 (&)[2][2][4][2], const Unit&, int, int) const {}
    __device__ __forceinline__ void operator()(const f32x4 (&acc)[2][2][4][2], const Unit& u, int wr, int wc, int fr, int fq) const {
        const int pn = u.pn, pm = u.pm;
        if (pn <= 2) {
            const bool isq = pn < 2, isk = (pn == 2) && (wc < 2), normed = isq || isk;
            const float* gp = isq ? gq : gk;
            f32x4 gv[2][2];
#pragma unroll
            for (int bj = 0; bj < 2; ++bj)
#pragma unroll
                for (int n = 0; n < 2; ++n) { f32x4 g = normed ? *(const f32x4*)(gp + 32 * bj + 8 * fq + 4 * n) : (f32x4){1.f, 1.f, 1.f, 1.f}; if (isq) g = g * E_QSCALE; gv[bj][n] = g; }
#pragma unroll
            for (int ai = 0; ai < 2; ++ai)
#pragma unroll
                for (int m = 0; m < 4; ++m) {
                    const int r = pm * BM + ai * HALF + wr * 64 + m * 16 + fr;
                    f32x4 v[2][2]; float ss = 0.f;
#pragma unroll
                    for (int bj = 0; bj < 2; ++bj)
#pragma unroll
                        for (int n = 0; n < 2; ++n) { v[bj][n] = acc[ai][bj][m][n]; const f32x4 x = v[bj][n]; ss += (x[0] * x[0] + x[1] * x[1]) + (x[2] * x[2] + x[3] * x[3]); }
                    float rs = 1.f;
                    if (normed) { ss += __shfl_xor(ss, 16); ss += __shfl_xor(ss, 32); rs = rsqrtf(ss * (1.0f / 64.0f) + E_EPS); }
                    u32x4 w[2];
#pragma unroll
                    for (int bj = 0; bj < 2; ++bj) { const f32x4 a = v[bj][0] * gv[bj][0] * rs, b = v[bj][1] * gv[bj][1] * rs;
                        w[bj].x = cvt_pk_bf16(a[0], a[1]); w[bj].y = cvt_pk_bf16(a[2], a[3]); w[bj].z = cvt_pk_bf16(b[0], b[1]); w[bj].w = cvt_pk_bf16(b[2], b[3]); }
                    if (isq) {
                        bf16_t* d = Q + (size_t)r * 512 + (4 * pn + wc) * 64 + 8 * fq;
                        *(u32x4*)(d) = w[0]; *(u32x4*)(d + 32) = w[1];
                    } else {
                        const int col = (wc & 1) * 64 + 8 * fq;
                        bf16_t* basep = isk ? Kp : Vp; bf16_t* bases = isk ? Ks : Vs;
                        if (pm < 128) { bf16_t* d = basep + (size_t)((pm >> 4) * E_KVS + 128 + (r & 4095)) * 128 + col; *(u32x4*)(d) = w[0]; *(u32x4*)(d + 32) = w[1]; }
                        else if (pm < 132) { bf16_t* d = bases + (size_t)(r - E_NROW_P) * 128 + col; *(u32x4*)(d) = w[0]; *(u32x4*)(d + 32) = w[1]; }
                        else { const int j = r - E_NROW; if (j < 16) {
#pragma unroll
                            for (int b = 0; b < 8; ++b) { bf16_t* d = basep + (size_t)(b * E_KVS + 112 + j) * 128 + col; *(u32x4*)(d) = w[0]; *(u32x4*)(d + 32) = w[1]; } } }
                    }
                }
        } else {
#pragma unroll
            for (int ai = 0; ai < 2; ++ai)
#pragma unroll
                for (int m = 0; m < 4; ++m) {
                    const int r = pm * BM + ai * HALF + wr * 64 + m * 16 + fr;
#pragma unroll
                    for (int bj = 0; bj < 2; ++bj) {
                        const f32x4 a = acc[ai][bj][m][0], b = acc[ai][bj][m][1];
                        u32x4 w; w.x = cvt_pk_bf16(a[0], a[1]); w.y = cvt_pk_bf16(a[2], a[3]); w.z = cvt_pk_bf16(b[0], b[1]); w.w = cvt_pk_bf16(b[2], b[3]);
                        const int g = 16 * (pn - 3) + 8 * bj + 2 * wc + (fq >> 1), ch = 8 * (fq & 1);
                        if (pm < 128) { *(u32x4*)(U + ((size_t)(g * 8 + (pm >> 4)) * E_KVS + 128 + (r & 4095)) * 16 + ch) = w; }
                        else if (pm < 132) { *(u32x4*)(Us + ((size_t)g * 1024 + (r - E_NROW_P)) * 16 + ch) = w; }
                        else { const int j = r - E_NROW; if (j < 16) {
#pragma unroll
                            for (int b2 = 0; b2 < 8; ++b2) *(u32x4*)(U + ((size_t)(g * 8 + b2) * E_KVS + 112 + j) * 16 + ch) = w; } }
                    }
                }
        }
    }
};

struct EpiOutProj {
    static constexpr bool PERM = false, AFTER_DRAIN = false, MIDSCALE = true;
    const float *xp, *xs; float* out; bf16_t* HB; const float *ssq_ssm, *ssq_att; float* ssq_h;
    __device__ __forceinline__ void mid(f32x4 (&acc)[2][2][4][2], const Unit& u, int wr, int fr) const {
        asm volatile("" : "+v"(fr));
#pragma unroll
        for (int ai = 0; ai < 2; ++ai)
#pragma unroll
            for (int m = 0; m < 4; ++m) {
                const int r = u.pm * BM + ai * HALF + wr * 64 + m * 16 + fr;
                const float ratio = sqrtf((ssq_att[r] * (1.0f / 512.0f) + E_EPS) / (ssq_ssm[r] * (1.0f / 512.0f) + E_EPS));
#pragma unroll
                for (int bj = 0; bj < 2; ++bj)
#pragma unroll
                    for (int n = 0; n < 2; ++n) acc[ai][bj][m][n] = acc[ai][bj][m][n] * ratio;
            }
    }
    __device__ __forceinline__ void operator()(const f32x4 (&acc)[2][2][4][2], const Unit& u, int wr, int wc, int fr, int fq) const {
        asm volatile("" : "+v"(fr), "+v"(fq));
        const int col0 = u.pn * BM + wc * 32 + 4 * fq;
#pragma unroll
        for (int ai = 0; ai < 2; ++ai)
#pragma unroll
            for (int m = 0; m < 4; ++m) {
                const int r = u.pm * BM + ai * HALF + wr * 64 + m * 16 + fr;
                const float ra = rsqrtf(ssq_att[r] * (1.0f / 512.0f) + E_EPS);
                const float* xrow = (r < E_NROW_P) ? xp + (size_t)r * 1024 : xs + (size_t)(r - E_NROW_P) * 1024;
                float s = 0.f;
#pragma unroll
                for (int bj = 0; bj < 2; ++bj)
#pragma unroll
                    for (int n = 0; n < 2; ++n) {
                        const int c = col0 + bj * HALF + n * 16;
                        const f32x4 h = *(const f32x4*)(xrow + c) + acc[ai][bj][m][n] * ra;
                        *(f32x4*)(out + (size_t)r * 1024 + c) = h;
                        u32x2 w; w.x = cvt_pk_bf16(h[0], h[1]); w.y = cvt_pk_bf16(h[2], h[3]);
                        *(u32x2*)(HB + (size_t)r * 1024 + c) = w;
                        s += (h[0] * h[0] + h[1] * h[1]) + (h[2] * h[2] + h[3] * h[3]);
                    }
                s += __shfl_xor(s, 16); s += __shfl_xor(s, 32);
                if (fq == 0) atomicAdd(ssq_h + r, s);
            }
    }
};

struct EpiGateUp {
    static constexpr bool PERM = true, AFTER_DRAIN = false, MIDSCALE = false;
    bf16_t* HFF; const float* ssq_h;
    __device__ __forceinline__ void mid(f32x4 (&)[2][2][4][2], const Unit&, int, int) const {}
    __device__ __forceinline__ void operator()(const f32x4 (&acc)[2][2][4][2], const Unit& u, int wr, int wc, int fr, int fq) const {
        const int col0 = u.pn * HALF + wc * 32 + 8 * fq;
#pragma unroll
        for (int ai = 0; ai < 2; ++ai)
#pragma unroll
            for (int m = 0; m < 4; ++m) {
                const int r = u.pm * BM + ai * HALF + wr * 64 + m * 16 + fr;
                const float rs = rsqrtf(ssq_h[r] * (1.0f / 1024.0f) + E_EPS);
                float o[8];
#pragma unroll
                for (int n = 0; n < 2; ++n)
#pragma unroll
                    for (int e = 0; e < 4; ++e) { const float g = acc[ai][0][m][n][e] * rs, up = acc[ai][1][m][n][e] * rs;
                        o[4 * n + e] = g * __builtin_amdgcn_rcpf(1.0f + __builtin_amdgcn_exp2f(-1.4426950408889634f * g)) * up; }
                u32x4 w; w.x = cvt_pk_bf16(o[0], o[1]); w.y = cvt_pk_bf16(o[2], o[3]); w.z = cvt_pk_bf16(o[4], o[5]); w.w = cvt_pk_bf16(o[6], o[7]);
                *(u32x4*)(HFF + (size_t)r * 2816 + col0) = w;
            }
    }
};

struct EpiDown {
    static constexpr bool PERM = false, AFTER_DRAIN = false, MIDSCALE = false;
    float* out;
    __device__ __forceinline__ void mid(f32x4 (&)[2][2][4][2], const Unit&, int, int) const {}
    __device__ __forceinline__ void operator()(const f32x4 (&acc)[2][2][4][2], const Unit& u, int wr, int wc, int fr, int fq) const {
        const int col0 = u.pn * BM + wc * 32 + 4 * fq;
#pragma unroll
        for (int ai = 0; ai < 2; ++ai)
#pragma unroll
            for (int m = 0; m < 4; ++m) {
                float* rowp = out + (size_t)(u.pm * BM + ai * HALF + wr * 64 + m * 16 + fr) * 1024 + col0;
#pragma unroll
                for (int bj = 0; bj < 2; ++bj)
#pragma unroll
                    for (int n = 0; n < 2; ++n) { float* p = rowp + bj * HALF + n * 16; *(f32x4*)p = *(const f32x4*)p + acc[ai][bj][m][n]; }
            }
    }
};

template <class Epi, class Sched, bool ALIGN_EPI = false, bool SP2 = false>
__device__ __forceinline__ void gemm_phase(PG8_LAS unsigned char* lds, const Gemm g, const Sched& S, const Epi& E) {
    const int tid = threadIdx.x, wid = __builtin_amdgcn_readfirstlane(tid >> 6), lane = tid & 63, wr = wid >> 2, wc = wid & 3, fr = lane & 15, fq = lane >> 4;
    const int K = g.K, nt = K / BK;
    unsigned voffA[2], voffB[2];
#pragma unroll
    for (int i = 0; i < 2; ++i) { int R, C; stage_rc(tid * 16 + i * 8192, R, C); const int Rb = Epi::PERM ? ((R & ~31) + perm32(R & 31)) : R;
        voffA[i] = (unsigned)(R * K + C) * 2u; voffB[i] = (unsigned)(Rb * K + C) * 2u; }
    const size_t kstep = (size_t)(BK * 2);
    const size_t hstep = (size_t)HALF * K * 2;
    const size_t tstep = 2 * hstep;
    const unsigned ldsw = (unsigned)wid * 1024u;
    const int aoff = lds_byte(wr * 64 + fr, fq * 8), boff = lds_byte(wc * 32 + fr, fq * 8);
#define PG8_SA(b, h) (((b) * 2 + (h)) * HTB)
#define PG8_SB(b, h) ((4 + (b) * 2 + (h)) * HTB)
#define PG8_STAGE(bufoff, gbase, voff) do { _Pragma("unroll") for (int _i = 0; _i < 2; ++_i) \
        __builtin_amdgcn_global_load_lds((const unsigned*)((const char*)(gbase) + (voff)[_i]), (PG8_LAS unsigned*)(lds + (bufoff) + ldsw + _i * 8192), 16, 0, 0); } while (0)
#define PG8_LDA(dst, b, h) do { _Pragma("unroll") for (int m = 0; m < 4; ++m) _Pragma("unroll") for (int k = 0; k < 2; ++k) dst[m][k] = *(const PG8_LAS bf16x8*)(lds + PG8_SA(b, h) + aoff + m * 2048 + k * 1024); } while (0)
#define PG8_LDB(dst, b, h) do { _Pragma("unroll") for (int n = 0; n < 2; ++n) _Pragma("unroll") for (int k = 0; k < 2; ++k) dst[n][k] = *(const PG8_LAS bf16x8*)(lds + PG8_SB(b, h) + boff + n * 2048 + k * 1024); } while (0)
#define PG8_MMA(ai, bj, At, Bt) do { __builtin_amdgcn_s_setprio(1); _Pragma("unroll") for (int m = 0; m < 4; ++m) _Pragma("unroll") for (int n = 0; n < 2; ++n) _Pragma("unroll") for (int k = 0; k < 2; ++k) \
        acc[ai][bj][m][n] = __builtin_amdgcn_mfma_f32_16x16x32_bf16(Bt[n][k], At[m][k], acc[ai][bj][m][n], 0, 0, 0); __builtin_amdgcn_s_setprio(0); } while (0)
#define PG8_WAIT_V(n) asm volatile("s_waitcnt vmcnt(" #n ")" ::: "memory")
#define PG8_WAIT_L(n) asm volatile("s_waitcnt lgkmcnt(" #n ")" ::: "memory")
#define PG8_BAR __builtin_amdgcn_s_barrier()
#define PG8_SCHED __builtin_amdgcn_sched_barrier(0)
    Unit cur, nxt; int ui = 0;
    if (!S.next(0, cur)) return;
    f32x4 acc[2][2][4][2];
#pragma unroll
    for (int a = 0; a < 2; ++a)
#pragma unroll
        for (int b = 0; b < 2; ++b)
#pragma unroll
            for (int m = 0; m < 4; ++m)
#pragma unroll
                for (int n = 0; n < 2; ++n) acc[a][b][m][n] = (f32x4){0.f, 0.f, 0.f, 0.f};
    bf16x8 At[4][2], B0[2][2], B1[2][2];
    const char* cA = (const char*)g.A + (size_t)cur.pm * tstep; const char* cB = (const char*)g.Bt + (size_t)cur.pn * tstep;
    S.a_ready(cur);
    if constexpr (SP2) {
        PG8_STAGE(PG8_SB(0, 0), cB, voffB); PG8_STAGE(PG8_SB(0, 1), cB + hstep, voffB); PG8_STAGE(PG8_SA(0, 0), cA, voffA); PG8_STAGE(PG8_SA(0, 1), cA + hstep, voffA);
        if (wr == 1) PG8_BAR;
        PG8_WAIT_V(2); PG8_BAR;
        PG8_STAGE(PG8_SB(1, 0), cB + kstep, voffB); PG8_STAGE(PG8_SA(1, 0), cA + kstep, voffA); PG8_STAGE(PG8_SB(1, 1), cB + hstep + kstep, voffB);
        PG8_WAIT_V(6); PG8_BAR;
    } else {
        PG8_STAGE(PG8_SB(0, 0), cB, voffB); PG8_STAGE(PG8_SA(0, 0), cA, voffA); PG8_STAGE(PG8_SB(0, 1), cB + hstep, voffB); PG8_STAGE(PG8_SA(0, 1), cA + hstep, voffA);
        if (wr == 1) PG8_BAR;
        PG8_WAIT_V(4); PG8_BAR;
        PG8_STAGE(PG8_SB(1, 0), cB + kstep, voffB); PG8_STAGE(PG8_SA(1, 0), cA + kstep, voffA); PG8_STAGE(PG8_SB(1, 1), cB + hstep + kstep, voffB);
        PG8_WAIT_V(6); PG8_BAR;
    }
    for (;;) {
        const bool has_next = S.next(ui + 1, nxt);
        const char* nA = has_next ? (const char*)g.A + (size_t)nxt.pm * tstep : cA; const char* nB = has_next ? (const char*)g.Bt + (size_t)nxt.pn * tstep : cB;
        for (int t = 0; t < nt; t += 2) {
            if constexpr (Epi::MIDSCALE) { if (t == (nt >> 1)) E.mid(acc, cur, wr, fr); }
            const bool last = (t == nt - 2);
            const char* a1 = cA + (size_t)(t + 1) * kstep;
            const char* a2 = last ? nA : cA + (size_t)(t + 2) * kstep; const char* b2 = last ? nB : cB + (size_t)(t + 2) * kstep;
            const char* a3 = a2 + kstep; const char* b3 = b2 + kstep;
            if (last && has_next) S.a_ready(nxt);
            if constexpr (SP2) {
            PG8_LDB(B0, 0, 0); PG8_LDB(B1, 0, 1); PG8_SCHED; PG8_LDA(At, 0, 0); PG8_STAGE(PG8_SA(1, 1), a1 + hstep, voffA);
            PG8_WAIT_V(8); PG8_WAIT_L(0); PG8_BAR; PG8_MMA(0, 0, At, B0); PG8_MMA(0, 1, At, B1); PG8_BAR; PG8_SCHED;
            PG8_LDA(At, 0, 1); PG8_STAGE(PG8_SB(0, 0), b2, voffB); PG8_STAGE(PG8_SB(0, 1), b2 + hstep, voffB); PG8_STAGE(PG8_SA(0, 0), a2, voffA);
            PG8_WAIT_V(8); PG8_WAIT_L(0); PG8_BAR; PG8_MMA(1, 0, At, B0); PG8_MMA(1, 1, At, B1); PG8_BAR; PG8_SCHED;
            PG8_LDB(B0, 1, 0); PG8_LDB(B1, 1, 1); PG8_SCHED; PG8_LDA(At, 1, 0); PG8_STAGE(PG8_SA(0, 1), a2 + hstep, voffA);
            PG8_WAIT_V(8); PG8_WAIT_L(0); PG8_BAR; PG8_MMA(0, 0, At, B0); PG8_MMA(0, 1, At, B1); PG8_BAR; PG8_SCHED;
            PG8_LDA(At, 1, 1); PG8_STAGE(PG8_SB(1, 0), b3, voffB); PG8_STAGE(PG8_SB(1, 1), b3 + hstep, voffB); PG8_STAGE(PG8_SA(1, 0), a3, voffA);
            PG8_WAIT_V(8); PG8_WAIT_L(0); PG8_BAR; PG8_MMA(1, 0, At, B0); PG8_MMA(1, 1, At, B1); PG8_BAR; PG8_SCHED;
            } else {
            PG8_LDB(B0, 0, 0); PG8_SCHED; PG8_LDA(At, 0, 0); PG8_STAGE(PG8_SA(1, 1), a1 + hstep, voffA);
            PG8_WAIT_L(8); PG8_BAR; PG8_WAIT_L(0); PG8_MMA(0, 0, At, B0); PG8_BAR; PG8_SCHED;
            PG8_LDB(B1, 0, 1); PG8_STAGE(PG8_SB(0, 0), b2, voffB);
            PG8_BAR; PG8_WAIT_L(0); PG8_MMA(0, 1, At, B1); PG8_BAR;
            PG8_LDA(At, 0, 1); PG8_STAGE(PG8_SA(0, 0), a2, voffA);
            PG8_BAR; PG8_WAIT_L(0); PG8_MMA(1, 0, At, B0); PG8_BAR; PG8_SCHED;
            PG8_STAGE(PG8_SB(0, 1), b2 + hstep, voffB);
            PG8_WAIT_V(6); PG8_BAR; PG8_MMA(1, 1, At, B1); PG8_BAR;
            PG8_LDB(B0, 1, 0); PG8_SCHED; PG8_LDA(At, 1, 0); PG8_STAGE(PG8_SA(0, 1), a2 + hstep, voffA);
            PG8_WAIT_L(8); PG8_BAR; PG8_WAIT_L(0); PG8_MMA(0, 0, At, B0); PG8_BAR; PG8_SCHED;
            PG8_LDB(B1, 1, 1); PG8_STAGE(PG8_SB(1, 0), b3, voffB);
            PG8_BAR; PG8_WAIT_L(0); PG8_MMA(0, 1, At, B1); PG8_BAR;
            PG8_LDA(At, 1, 1); PG8_STAGE(PG8_SA(1, 0), a3, voffA);
            PG8_BAR; PG8_WAIT_L(0); PG8_MMA(1, 0, At, B0); PG8_BAR; PG8_SCHED;
            PG8_STAGE(PG8_SB(1, 1), b3 + hstep, voffB);
            PG8_WAIT_V(6); PG8_BAR; PG8_MMA(1, 1, At, B1); PG8_BAR;
            }
        }
        if constexpr (ALIGN_EPI) { if (wr == 0) PG8_BAR; }
        if constexpr (!Epi::AFTER_DRAIN) { E(acc, cur, wr, wc, fr, fq); S.done(cur); }
        if (!has_next) break;
#pragma unroll
        for (int a = 0; a < 2; ++a)
#pragma unroll
            for (int b = 0; b < 2; ++b)
#pragma unroll
                for (int m = 0; m < 4; ++m)
#pragma unroll
                    for (int n = 0; n < 2; ++n) acc[a][b][m][n] = (f32x4){0.f, 0.f, 0.f, 0.f};
        cur = nxt; cA = nA; cB = nB; ++ui;
        if constexpr (ALIGN_EPI) { if (wr == 1) PG8_BAR; }
    }
    PG8_WAIT_V(0);
    if constexpr (!ALIGN_EPI) { if (wr == 0) PG8_BAR; }
    PG8_BAR;
    if constexpr (Epi::AFTER_DRAIN) { E.fused(acc, cur, wr, wc, fr, fq, lds, wid, lane); S.done(cur); }
#undef PG8_SA
#undef PG8_SB
#undef PG8_STAGE
#undef PG8_LDA
#undef PG8_LDB
#undef PG8_MMA
#undef PG8_WAIT_V
#undef PG8_WAIT_L
#undef PG8_BAR
#undef PG8_SCHED
}
}


#ifndef PG8_SP2
#define PG8_SP2 true
#endif
#ifndef PG8_ALIGN
#define PG8_ALIGN true
#endif
constexpr int N_LAUNCHES = MK_N_LAUNCHES;
constexpr int PER_PHASE = 6;
constexpr int CW_TMO = 0, CW_CODE = 1;
constexpr int CW_BAR = 4096;

#define XB_TMO      128
#define XB_XCNT(j)  (256  + 64 * (j))
#define XB_XSUB(j)  (1280 + 64 * (j))
#define XB_XGEN(j)  (2304 + 64 * (j))
#define XB_TOP      3328
#define XB_TOPGEN   3392
#define XCD_BAR_WORDS 3456
#define XB_SPIN_CAP (1u << 18)

__device__ __forceinline__ unsigned xb_ld(unsigned* p)              { return __hip_atomic_load(p, __ATOMIC_RELAXED, __HIP_MEMORY_SCOPE_AGENT); }
__device__ __forceinline__ unsigned xb_add(unsigned* p, unsigned v) { return __hip_atomic_fetch_add(p, v, __ATOMIC_RELAXED, __HIP_MEMORY_SCOPE_AGENT); }
__device__ __forceinline__ unsigned xb_xcc_id() { return (unsigned)__builtin_amdgcn_s_getreg((3 << 11) | 20) & 0xFu; }
#define XB_SPIN(cond, bar) do { unsigned _sp = 0; while (cond) { __builtin_amdgcn_s_sleep(1); \
    if ((++_sp & 255u) == 0u) { if (xb_ld(&(bar)[XB_TMO])) break; if (_sp > XB_SPIN_CAP) { atomicAdd(&(bar)[XB_TMO], 1u); break; } } } } while (0)

struct XcdBarrier {
    unsigned* bar; unsigned x;
    volatile LAS unsigned* st;
};

__device__ __forceinline__ XcdBarrier xcd_barrier_post(unsigned* bar, volatile LAS unsigned* st) {
    XcdBarrier b; b.bar = bar; b.x = xb_xcc_id(); b.st = st;
    if (threadIdx.x == 0) (void)xb_add(&bar[XB_XCNT(b.x)], 1u);
    return b;
}
__device__ __forceinline__ void xcd_barrier_complete(unsigned* bar, unsigned x, unsigned& nloc, unsigned& nx) {
    const unsigned G = gridDim.x * gridDim.y * gridDim.z;
    unsigned sum, cnt, mine, sp = 0u;
    for (;;) {
        sum = 0u; cnt = 0u; mine = 0u;
#pragma unroll
        for (unsigned j = 0; j < 16; ++j) { const unsigned c = xb_ld(&bar[XB_XCNT(j)]); sum += c; cnt += (c > 0u) ? 1u : 0u; mine = (j == x) ? c : mine; }
        if (sum == G) break;
        __builtin_amdgcn_s_sleep(1);
        if ((++sp & 255u) == 0u) { if (xb_ld(&bar[XB_TMO])) break; if (sp > XB_SPIN_CAP) { atomicAdd(&bar[XB_TMO], 1u); break; } }
    }
    nloc = mine > 0u ? mine : 1u; nx = cnt > 0u ? cnt : 1u;
}

__device__ __forceinline__ void xcd_barrier(const XcdBarrier& b) {
    asm volatile("s_waitcnt vmcnt(0)" ::: "memory");
    __syncthreads();
    if (threadIdx.x == 0) {
        unsigned* bar = b.bar;
        __builtin_amdgcn_s_waitcnt(0);
        unsigned nloc = b.st[0], nx = b.st[1];
        if (nloc == 0u) { xcd_barrier_complete(bar, b.x, nloc, nx); b.st[0] = nloc; b.st[1] = nx; }
        const unsigned old = xb_add(&bar[XB_XSUB(b.x)], 1u);
        const unsigned gen = old / nloc;
        if (old + 1u == (gen + 1u) * nloc) {
            __builtin_amdgcn_fence(__ATOMIC_RELEASE, "agent");
            asm volatile("s_waitcnt vmcnt(0)" ::: "memory");
            const unsigned og = xb_add(&bar[XB_TOP], 1u);
            const unsigned tg = og / nx;
            if (og + 1u == (tg + 1u) * nx) xb_add(&bar[XB_TOPGEN], 1u);
            else XB_SPIN(xb_ld(&bar[XB_TOPGEN]) == tg, bar);
            __builtin_amdgcn_fence(__ATOMIC_ACQUIRE, "agent");
            xb_add(&bar[XB_XGEN(b.x)], 1u);
            asm volatile("s_waitcnt vmcnt(0)" ::: "memory");
        } else {
            XB_SPIN(xb_ld(&bar[XB_XGEN(b.x)]) == gen, bar);
            __builtin_amdgcn_fence(__ATOMIC_ACQUIRE, "agent");
            asm volatile("s_waitcnt vmcnt(0)" ::: "memory");
        }
    }
    __syncthreads();
}


struct Frame {
    LAS unsigned char* lds;
    volatile LAS unsigned* MISC;
    gu32* ctl;
    int tid, lane, wave;
    int vcu, G;
    const float* in[29];
    float* out;
    unsigned char* ws;
};
#define WSP(T, off) ((T*)(F.ws + (off)))

__device__ __forceinline__ void tr_item(const float* W, int ldw, int src_k0, int src_n0, const float* kscale, bf16* WT, int ldwt, int dst_n0, int dst_k0, LAS float* scr, int lane) {
#pragma unroll 8
    for (int i = 0; i < 32; ++i) { const int kk = 2 * i + (lane >> 5); float v = W[(size_t)(src_k0 + kk) * ldw + src_n0 + (lane & 31)]; if (kscale) v *= kscale[kk]; scr[kk * 33 + (lane & 31)] = v; }
    LDS_WAIT(); asm volatile("" ::: "memory");
    const int c = lane & 7;
#pragma unroll
    for (int j = 0; j < 4; ++j) { const int n = (lane >> 3) + 8 * j; const LAS float* s = scr + (8 * c) * 33 + n;
        v4u o; o.x = pk2(s[0 * 33], s[1 * 33]); o.y = pk2(s[2 * 33], s[3 * 33]); o.z = pk2(s[4 * 33], s[5 * 33]); o.w = pk2(s[6 * 33], s[7 * 33]);
        *(GAS v4u*)(WT + (size_t)(dst_n0 + n) * ldwt + dst_k0 + 8 * c) = o; }
    LDS_WAIT(); asm volatile("" ::: "memory");
}
__device__ __forceinline__ void p0_prologue(Frame& F) {
    LAS float* scr = (LAS float*)(F.lds + RING_OFF + F.wave * 16384);
    const int gw = F.vcu * NWAVES + F.wave, NGW = F.G * NWAVES, lane = F.lane;
    constexpr int I_IN = 16 * 40, I_O = 16 * 32, I_GU = 16 * 176, I_D = 44 * 32, NITEMS = I_IN + I_O + I_GU + I_D;
    for (int it = gw; it < NITEMS; it += NGW) {
        int r = it;
        if (r < I_IN) { const int kb = r / 40, nb = r % 40, n0 = 32 * nb; int s0 = n0;
            if (n0 < 768) { const int pn = n0 >> 8, ct = n0 & 255; s0 = 256 * pn + 64 * ((ct & 127) >> 5) + 32 * (ct >> 7); }
            tr_item(F.in[8], INC, 64 * kb, s0, nullptr, WSP(bf16, WS_WIN), DM, n0, 64 * kb, scr, lane); continue; }
        r -= I_IN;
        if (r < I_O) { const int kb = r / 32, nb = r % 32, k0 = 64 * kb;
            const int sk = k0 < 512 ? k0 + 512 : k0 - 512; const float* ks = k0 < 512 ? F.in[23] + k0 : F.in[22] + (k0 - 512);
            tr_item(F.in[24], DM, sk, 32 * nb, ks, WSP(bf16, WS_WO), DM, 32 * nb, k0, scr, lane); continue; }
        r -= I_O;
        if (r < I_GU) { const int kb = r / 176, nb = r % 176, n0 = 32 * nb, pn = n0 >> 8, ct = n0 & 255;
            const float* W = ct < 128 ? F.in[26] : F.in[27];
            tr_item(W, DFF, 64 * kb, 128 * pn + (ct & 127), F.in[25] + 64 * kb, WSP(bf16, WS_WGU), DM, n0, 64 * kb, scr, lane); continue; }
        r -= I_GU;
        { const int kb = r / 32, nb = r % 32; tr_item(F.in[28], DM, 64 * kb, 32 * nb, nullptr, WSP(bf16, WS_WD), DFF, 32 * nb, 64 * kb, scr, lane); }
    }
    {
        const GAS v4f* gp = (const GAS v4f*)F.in[7] + lane;
        v4f g[4];
#pragma unroll
        for (int j = 0; j < 4; ++j) g[j] = gp[64 * j];
        bf16* XN = WSP(bf16, WS_XN);
        for (int r = gw; r < NROW_IN; r += NGW) {
            GAS unsigned long long* o8 = (GAS unsigned long long*)(XN + (size_t)r * DM) + lane;
            if (r >= ROW_META + NMETA) {
#pragma unroll
                for (int j = 0; j < 4; ++j) o8[64 * j] = 0ull;
                continue;
            }
            const float* xrow = r < NROW_P ? F.in[0] + (size_t)r * DM : (r < NROW ? F.in[1] + (size_t)(r - NROW_P) * DM : F.in[6] + (size_t)(r - NROW) * DM);
            const GAS v4f* xr = (const GAS v4f*)xrow + lane;
            v4f v[4]; float s = 0.f;
#pragma unroll
            for (int j = 0; j < 4; ++j) { v[j] = xr[64 * j]; s += (v[j].x * v[j].x + v[j].y * v[j].y) + (v[j].z * v[j].z + v[j].w * v[j].w); }
            const float rstd = rsqrtf(wave_sum(s) * (1.f / DM) + EPS);
#pragma unroll
            for (int j = 0; j < 4; ++j) { const v4f y = v[j] * g[j] * rstd; o8[64 * j] = (unsigned long long)pk2(y.x, y.y) | ((unsigned long long)pk2(y.z, y.w) << 32); }
        }
    }
    {
        const int gt = gw * 64 + lane, NT = NGW * 64;
        GAS v4f* ssq = (GAS v4f*)WSP(float, WS_SSQ);
        for (int i = gt; i < 3 * NROW / 4; i += NT) ssq[i] = (v4f){0.f, 0.f, 0.f, 0.f};
        for (int i = gt; i < 256 * 224; i += NT) { const int gb = i / 224, w = i % 224; *(GAS v4u*)(F.ws + WS_U + (size_t)gb * KVS * 32 + (size_t)w * 16) = (v4u){0u, 0u, 0u, 0u}; }
        for (int i = gt; i < 8 * 1792; i += NT) { const int b = i / 1792, w = i % 1792;
            *(GAS v4u*)(F.ws + WS_KP + (size_t)b * KVS * 256 + (size_t)w * 16) = (v4u){0u, 0u, 0u, 0u}; *(GAS v4u*)(F.ws + WS_VP + (size_t)b * KVS * 256 + (size_t)w * 16) = (v4u){0u, 0u, 0u, 0u}; }
        for (int i = gt; i < DECB * 3840; i += NT) { const int db = i / 3840, w = i % 3840;
            ((GAS v4f*)(F.out + O_KWS + (size_t)db * 16384))[w] = ((const GAS v4f*)(F.in[2] + (size_t)db * 16384 + 1024))[w];
            ((GAS v4f*)(F.out + O_VWS + (size_t)db * 16384))[w] = ((const GAS v4f*)(F.in[3] + (size_t)db * 16384 + 1024))[w]; }
    }
}

__device__ __forceinline__ void unpack8(const v4u w, float* f) { f[0] = bflo(w.x); f[1] = bfhi(w.x); f[2] = bflo(w.y); f[3] = bfhi(w.y); f[4] = bflo(w.z); f[5] = bfhi(w.z); f[6] = bflo(w.w); f[7] = bfhi(w.w); }
__device__ __forceinline__ void p2_simple_attn(Frame& F) {
    LAS float* pw = (LAS float*)(F.lds + RING_OFF) + F.wave * 192;
    const int gw = F.vcu * NWAVES + F.wave, NGW = F.G * NWAVES, lane = F.lane;
    const bf16 *Q = WSP(bf16, WS_Q), *Kp = WSP(bf16, WS_KP), *Vp = WSP(bf16, WS_VP), *Ks = WSP(bf16, WS_KS), *Vs = WSP(bf16, WS_VS);
    bf16* MIX = WSP(bf16, WS_MIX); float* ssq_att = WSP(float, WS_SSQ) + NROW;
    const float *ck = F.in[2], *cv = F.in[3];
    for (int it = gw; it < NROW * NHQ; it += NGW) {
        const int r = it >> 3, h = it & 7, kvh = h >> 2;
        float q[64];
        { const v4u* qp = (const v4u*)(Q + (size_t)r * 512 + h * 64);
#pragma unroll
          for (int j = 0; j < 8; ++j) unpack8(qp[j], q + 8 * j); }
        const float sink = F.in[11][h] * LOG2E;
        const bool prompt = r < NROW_P;
        const int b = r >> 12, i = r & 4095, sr = r - NROW_P, db = sr >> 3, s = sr & 7;
        float sc[3];
#pragma unroll
        for (int rnd = 0; rnd < 3; ++rnd) {
            const int jj = lane + 64 * rnd; bool valid = jj <= WIN; const int jc = valid ? jj : 0; float d = 0.f;
            if (prompt) {
                const int rho = i + jc; valid = valid && (rho >= 112);
                const v4u* kp = (const v4u*)(Kp + (size_t)(b * KVS + rho) * 128 + kvh * 64);
#pragma unroll
                for (int j = 0; j < 8; ++j) { float kf[8]; unpack8(kp[j], kf);
#pragma unroll
                    for (int e = 0; e < 8; ++e) d += q[8 * j + e] * kf[e]; }
            } else {
                const int j2 = s + jc;
                if (j2 < WIN) { const v4f* kp = (const v4f*)(ck + ((size_t)(db * WIN + j2) * 2 + kvh) * 64);
#pragma unroll
                    for (int j = 0; j < 16; ++j) { const v4f kf = kp[j]; d += q[4 * j] * kf.x + q[4 * j + 1] * kf.y + q[4 * j + 2] * kf.z + q[4 * j + 3] * kf.w; } }
                else { const v4u* kp = (const v4u*)(Ks + (size_t)(db * 8 + (j2 - WIN)) * 128 + kvh * 64);
#pragma unroll
                    for (int j = 0; j < 8; ++j) { float kf[8]; unpack8(kp[j], kf);
#pragma unroll
                        for (int e = 0; e < 8; ++e) d += q[8 * j + e] * kf[e]; } }
            }
            sc[rnd] = valid ? d : -INFINITY;
        }
        float m = wave_max(fmaxf(fmaxf(sc[0], sc[1]), sc[2])); m = fmaxf(m, sink);
        float psum = 0.f;
#pragma unroll
        for (int rnd = 0; rnd < 3; ++rnd) { const float p = __builtin_amdgcn_exp2f(sc[rnd] - m); psum += p; pw[lane + 64 * rnd] = p; }
        const float denom = wave_sum(psum) + __builtin_amdgcn_exp2f(sink - m);
        LDS_WAIT(); asm volatile("" ::: "memory");
        float o = 0.f;
        if (prompt) {
            const bf16* vp = Vp + (size_t)(b * KVS + i) * 128 + kvh * 64 + lane;
            for (int jj = 0; jj <= WIN; ++jj) o += pw[jj] * bf2f(vp[(size_t)jj * 128]);
        } else {
            for (int jj = 0; jj <= WIN; ++jj) { const int j2 = s + jj;
                const float v = j2 < WIN ? cv[((size_t)(db * WIN + j2) * 2 + kvh) * 64 + lane] : bf2f(Vs[(size_t)(db * 8 + (j2 - WIN)) * 128 + kvh * 64 + lane]);
                o += pw[jj] * v; }
        }
        o = o / denom;
        MIX[(size_t)r * DM + 512 + h * 64 + lane] = (bf16)f2bf(o);
        const float ss = wave_sum(o * o);
        if (lane == 0) atomicAdd(ssq_att + r, ss);
        LDS_WAIT(); asm volatile("" ::: "memory");
    }
    {
        const int gt = gw * 64 + lane, NT = NGW * 64;
        for (int i2 = gt; i2 < NBATCH * WIN * 128; i2 += NT) { const int b = i2 >> 14, w = (i2 >> 7) & 127, c = i2 & 127;
            F.out[O_KWP + i2] = bf2f(Kp[(size_t)(b * KVS + 4096 + w) * 128 + c]); F.out[O_VWP + i2] = bf2f(Vp[(size_t)(b * KVS + 4096 + w) * 128 + c]); }
        for (int i2 = gt; i2 < DECB * DECS * 128; i2 += NT) { const int db = i2 >> 10, s = (i2 >> 7) & 7, c = i2 & 127;
            F.out[O_KWS + (size_t)db * 16384 + (120 + s) * 128 + c] = bf2f(Ks[i2]); F.out[O_VWS + (size_t)db * 16384 + (120 + s) * 128 + c] = bf2f(Vs[i2]); }
    }
}
__device__ __forceinline__ void p2_simple_ssm(Frame& F) {
    const int gw = F.vcu * NWAVES + F.wave, NGW = F.G * NWAVES, lane = F.lane, p = lane;
    const bf16 *U = WSP(bf16, WS_U), *Us = WSP(bf16, WS_US);
    bf16* MIX = WSP(bf16, WS_MIX); float* ssq_ssm = WSP(float, WS_SSQ);
    for (int it = gw; it < 256 + NG * DECB; it += NGW) {
        const bool prompt = it < 256; const int g = prompt ? (it & 31) : ((it - 256) & 31), bb = prompt ? (it >> 5) : ((it - 256) >> 5);
        const float dt = expf(F.in[14][g]), ar = F.in[12][g * 64 + p], ai = F.in[13][g * 64 + p];
        const float th = ai * dt, mag = expf(ar * dt), cs = cosf(th), sn = sinf(th), lr = mag * cs, li = mag * sn;
        const float sh = sinf(0.5f * th), nr = expm1f(ar * dt) * cs - 2.f * sh * sh, ni = li, den = ar * ar + ai * ai;
        const float fr_ = (nr * ar + ni * ai) / den, fi_ = (ni * ar - nr * ai) / den;
        float bbr[16], bbi[16], cr[16], ci[16], dsk[16], wk[16];
#pragma unroll
        for (int h = 0; h < 16; ++h) { const float br = F.in[15][(size_t)(g * 64 + p) * 16 + h], bi = F.in[16][(size_t)(g * 64 + p) * 16 + h];
            bbr[h] = fr_ * br - fi_ * bi; bbi[h] = fr_ * bi + fi_ * br;
            cr[h] = F.in[17][(size_t)(g * 16 + h) * 64 + p]; ci[h] = F.in[18][(size_t)(g * 16 + h) * 64 + p];
            dsk[h] = F.in[19][g * 16 + h]; wk[h] = F.in[20][(size_t)(g * 16 + h) * 16 + (lane & 15)]; }
        const float bg = F.in[21][g * 16 + (lane & 15)];
        float hr = 0.f, hi = 0.f;
        if (!prompt) { hr = F.in[4][(size_t)(bb * 32 + g) * 64 + p]; hi = F.in[5][(size_t)(bb * 32 + g) * 64 + p]; }
        const int ntok = prompt ? (NMETA + SEQ) : DECS;
        const bf16* ubase = prompt ? U + ((size_t)(g * 8 + bb) * KVS + 112) * 16 : Us + ((size_t)g * 1024 + bb * 8) * 16;
        for (int t = 0; t < ntok; ++t) {
            const v4u* up = (const v4u*)(ubase + (size_t)t * 16);
            float u[16]; unpack8(up[0], u); unpack8(up[1], u + 8);
            float xr = 0.f, xi = 0.f;
#pragma unroll
            for (int h = 0; h < 16; ++h) { xr += bbr[h] * u[h]; xi += bbi[h] * u[h]; }
            const float nhr = lr * hr - li * hi + xr, nhi = lr * hi + li * hr + xi; hr = nhr; hi = nhi;
            float gl[16];
#pragma unroll
            for (int h = 0; h < 16; ++h) { const float y = wave_sum(cr[h] * hr - ci[h] * hi) + dsk[h] * u[h]; gl[h] = gelu_tanh(y); }
            float gate = bg, glk = 0.f;
#pragma unroll
            for (int h = 0; h < 16; ++h) { gate += gl[h] * wk[h]; glk = ((lane & 15) == h) ? gl[h] : glk; }
            const float o = glk * sigmoidf_(gate);
            float ss = o * o; ss += __shfl_xor(ss, 1); ss += __shfl_xor(ss, 2); ss += __shfl_xor(ss, 4); ss += __shfl_xor(ss, 8);
            const int row = prompt ? (t >= NMETA ? bb * SEQ + t - NMETA : -1) : NROW_P + bb * 8 + t;
            if (row >= 0 && lane < 16) { MIX[(size_t)row * DM + g * 16 + lane] = (bf16)f2bf(o); if (lane == 0) atomicAdd(ssq_ssm + row, ss); }
        }
        if (prompt) { F.out[O_SRP + (size_t)(bb * 32 + g) * 64 + p] = hr; F.out[O_SIP + (size_t)(bb * 32 + g) * 64 + p] = hi; }
        else { F.out[O_SRS + (size_t)(bb * 32 + g) * 64 + p] = hr; F.out[O_SIS + (size_t)(bb * 32 + g) * 64 + p] = hi; }
    }
}

struct Args { const float* in[29]; float* out; unsigned char* ws; int ph_lo, ph_hi; };
__global__ void __launch_bounds__(NWAVES * 64, 2) hymba_fwd(Args args) {
    extern __shared__ __attribute__((aligned(16))) unsigned char lds[];
    Frame F;
    F.lds = (LAS unsigned char*)lds;
    F.MISC = (volatile LAS unsigned*)(F.lds + MISC_OFF);
    F.tid = threadIdx.x; F.lane = F.tid & 63; F.wave = __builtin_amdgcn_readfirstlane(F.tid >> 6);
    F.G = gridDim.x; { const int bx = blockIdx.x; F.vcu = (F.G % 8 == 0) ? (bx % 8) * (F.G / 8) + bx / 8 : bx; }
    F.ws = args.ws; F.out = args.out; F.ctl = (gu32*)(args.ws + WS_CTL);
#pragma unroll
    for (int i = 0; i < 29; ++i) F.in[i] = args.in[i];
    for (int u = F.tid; u < (LDS_BYTES - LDSCTL_OFF) / 4; u += NWAVES * 64) ((LAS unsigned*)(F.lds + LDSCTL_OFF))[u] = 0u;
    __syncthreads();
    XcdBarrier bar; bar.bar = (unsigned*)(F.ctl + CW_BAR); bar.x = 0; bar.st = nullptr;
    if (N_LAUNCHES != PER_PHASE) bar = xcd_barrier_post((unsigned*)(F.ctl + CW_BAR), F.MISC + 8);
#define GRID_BAR() do { if (N_LAUNCHES != PER_PHASE) xcd_barrier(bar); } while (0)
    const int lo = args.ph_lo, hi = args.ph_hi;
#define IN(k) (lo <= (k) && (k) < hi)
#define BOTH(k) (IN(k) && IN((k) + 1))

    if (IN(0)) { p0_prologue(F); if (BOTH(0)) GRID_BAR(); }

    if (IN(1)) {
        pg8::Gemm g{WSP(bf16, WS_XN), WSP(bf16, WS_WIN), NROW_IN, INC, DM}; pg8::StaticOrder S; S.init(NROW_IN, INC, F.G, (int)blockIdx.x);
        pg8::EpiInProj E{WSP(bf16, WS_Q), WSP(bf16, WS_KP), WSP(bf16, WS_VP), WSP(bf16, WS_KS), WSP(bf16, WS_VS), WSP(bf16, WS_U), WSP(bf16, WS_US), F.in[9], F.in[10]};
        pg8::gemm_phase<pg8::EpiInProj, pg8::StaticOrder, PG8_ALIGN, PG8_SP2>(F.lds + RING_OFF, g, S, E);
        if (BOTH(1)) GRID_BAR();
    }

    if (IN(2)) { p2_simple_ssm(F); p2_simple_attn(F); if (BOTH(2)) GRID_BAR(); }

    if (IN(3)) {
        pg8::Gemm g{WSP(bf16, WS_MIX), WSP(bf16, WS_WO), NROW, DM, DM}; pg8::StaticOrder S; S.init(NROW, DM, F.G, (int)blockIdx.x);
        pg8::EpiOutProj E{F.in[0], F.in[1], F.out, WSP(bf16, WS_HB), WSP(float, WS_SSQ), WSP(float, WS_SSQ) + NROW, WSP(float, WS_SSQ) + 2 * NROW};
        pg8::gemm_phase<pg8::EpiOutProj, pg8::StaticOrder, PG8_ALIGN, PG8_SP2>(F.lds + RING_OFF, g, S, E);
        if (BOTH(3)) GRID_BAR();
    }

    if (IN(4)) {
        pg8::Gemm g{WSP(bf16, WS_HB), WSP(bf16, WS_WGU), NROW, NGU, DM}; pg8::StaticOrder S; S.init(NROW, NGU, F.G, (int)blockIdx.x);
        pg8::EpiGateUp E{WSP(bf16, WS_HFF), WSP(float, WS_SSQ) + 2 * NROW};
        pg8::gemm_phase<pg8::EpiGateUp, pg8::StaticOrder, PG8_ALIGN, PG8_SP2>(F.lds + RING_OFF, g, S, E);
        if (BOTH(4)) GRID_BAR();
    }

    if (IN(5)) {
        pg8::Gemm g{WSP(bf16, WS_HFF), WSP(bf16, WS_WD), NROW, DM, DFF}; pg8::StaticOrder S; S.init(NROW, DM, F.G, (int)blockIdx.x);
        pg8::EpiDown E{F.out};
        pg8::gemm_phase<pg8::EpiDown, pg8::StaticOrder, PG8_ALIGN, PG8_SP2>(F.lds + RING_OFF, g, S, E);
    }
#undef IN
#undef BOTH
}

extern "C" void kernel_launch(void* const* d_in, const int* in_sizes, int n_in, void* d_out, int out_size, void* d_ws, size_t ws_size, hipStream_t stream) {
    static int grid = 0;
    if (grid == 0) {
        if (n_in != 29 || out_size != (int)O_END || ws_size < WS_END) { fprintf(stderr, "kernel_launch: unexpected shapes: n_in %d out %d ws %zu; nothing launched\n", n_in, out_size, ws_size); grid = -1; return; }
        int dev = 0, cus = 0, per_cu = 0;
        if (hipGetDevice(&dev) != hipSuccess || hipDeviceGetAttribute(&cus, hipDeviceAttributeMultiprocessorCount, dev) != hipSuccess) { grid = -1; return; }
        if (hipFuncSetAttribute((const void*)hymba_fwd, hipFuncAttributeMaxDynamicSharedMemorySize, LDS_BYTES) != hipSuccess) { fprintf(stderr, "kernel_launch: hipFuncSetAttribute failed\n"); grid = -1; return; }
        if (hipOccupancyMaxActiveBlocksPerMultiprocessor(&per_cu, (const void*)hymba_fwd, NWAVES * 64, LDS_BYTES) != hipSuccess || per_cu < 1)
            fprintf(stderr, "kernel_launch: note: occupancy query reports %d workgroups per CU\n", per_cu);
        (void)hipGetLastError();
        grid = cus;
    }
    if (grid < 0) return;
    if (hipMemsetAsync((char*)d_ws + WS_CTL, 0, CTL_ZERO_BYTES, stream) != hipSuccess) { fprintf(stderr, "kernel_launch: hipMemsetAsync failed\n"); return; }
    Args a{};
    for (int i = 0; i < 29; ++i) a.in[i] = (const float*)d_in[i];
    a.out = (float*)d_out; a.ws = (unsigned char*)d_ws;
    if (N_LAUNCHES == 1) {
        a.ph_lo = 0; a.ph_hi = PER_PHASE;
        hipLaunchKernelGGL(hymba_fwd, dim3(grid), dim3(NWAVES * 64), LDS_BYTES, stream, a);
    } else {
        for (int li = 0; li < PER_PHASE; ++li) { a.ph_lo = li; a.ph_hi = li + 1; hipLaunchKernelGGL(hymba_fwd, dim3(grid), dim3(NWAVES * 64), LDS_BYTES, stream, a); }
    }
    const hipError_t le = hipPeekAtLastError();
    if (le != hipSuccess) fprintf(stderr, "kernel_launch: launch failed: %s\n", hipGetErrorName(le));
}
```

```cpp
#include <hip/hip_runtime.h>
#include <cstdio>
#include <cstdint>
#include <cmath>

#ifndef MK_N_LAUNCHES
#define MK_N_LAUNCHES 1
#endif

constexpr int DM = 1024, NBATCH = 8, SEQ = 4096, NMETA = 16, DECB = 128, DECS = 8;
constexpr int NROW_P = NBATCH * SEQ;
constexpr int NROW_S = DECB * DECS;
constexpr int NROW = NROW_P + NROW_S;
constexpr int ROW_META = NROW;
constexpr int NROW_IN = 34048;
constexpr int INC = 1280, DFF = 2816, NGU = 2 * DFF;
constexpr int KVS = 4224;
constexpr int NHQ = 8, NKV = 2, HD = 64, NG = 32, GH = 16, NP = 64, WIN = 128;
constexpr float EPS = 1e-6f;
constexpr float LOG2E = 1.4426950408889634f;
constexpr float QSCALE = 0.125f * LOG2E;

constexpr size_t O_Y = 0;
constexpr size_t O_KWP = (size_t)NROW * DM;
constexpr size_t O_VWP = O_KWP + 131072;
constexpr size_t O_SRP = O_VWP + 131072;
constexpr size_t O_SIP = O_SRP + 16384;
constexpr size_t O_KWS = O_SIP + 16384;
constexpr size_t O_VWS = O_KWS + 2097152;
constexpr size_t O_SRS = O_VWS + 2097152;
constexpr size_t O_SIS = O_SRS + 262144;
constexpr size_t O_END = O_SIS + 262144;

constexpr size_t MiB = 1u << 20;
constexpr size_t WS_CTL = 0, CTL_ZERO_BYTES = 1 * MiB;
constexpr size_t WS_WIN = 2 * MiB;
constexpr size_t WS_WO = 5 * MiB;
constexpr size_t WS_WGU = 7 * MiB;
constexpr size_t WS_WD = 18 * MiB;
constexpr size_t WS_SSMC = 24 * MiB;
constexpr size_t WS_SSQ = 28 * MiB;
constexpr size_t WS_KS = 29 * MiB;
constexpr size_t WS_VS = WS_KS + 512 * 1024;
constexpr size_t WS_US = 30 * MiB;
constexpr size_t WS_MIX = 32 * MiB;
constexpr size_t WS_HB = 98 * MiB;
constexpr size_t WS_HFF = 164 * MiB;
constexpr size_t WS_XN = 164 * MiB;
constexpr size_t WS_Q = 231 * MiB;
constexpr size_t WS_KP = 265 * MiB;
constexpr size_t WS_VP = 274 * MiB;
constexpr size_t WS_U = 283 * MiB;
constexpr size_t WS_END = 346 * MiB;
static_assert(WS_XN + (size_t)NROW_IN * DM * 2 <= WS_Q && WS_Q + (size_t)NROW_IN * 512 * 2 <= WS_KP && WS_KP + (size_t)NBATCH * KVS * 128 * 2 <= WS_VP &&
              WS_VP + (size_t)NBATCH * KVS * 128 * 2 <= WS_U && WS_U + (size_t)NG * NBATCH * KVS * 16 * 2 <= WS_END && WS_HFF + (size_t)NROW * DFF * 2 <= WS_END &&
              WS_MIX + (size_t)NROW * DM * 2 <= WS_HB && WS_HB + (size_t)NROW * DM * 2 <= WS_HFF && WS_WD + (size_t)DM * DFF * 2 <= WS_SSMC, "d_ws map");

constexpr int RING_OFF = 0, RING_BYTES = 131072;
constexpr int LDSCTL_OFF = RING_BYTES, MISC_OFF = LDSCTL_OFF + 320;
constexpr int LDS_BYTES = 147456;
constexpr int NWAVES = 8;

#define GAS __attribute__((address_space(1)))
#define LAS __attribute__((address_space(3)))
typedef unsigned short bf16;
typedef unsigned v4u __attribute__((ext_vector_type(4)));
typedef unsigned v2u __attribute__((ext_vector_type(2)));
typedef float v4f __attribute__((ext_vector_type(4)));
typedef GAS unsigned gu32;
#define RLX_AGENT __ATOMIC_RELAXED, __HIP_MEMORY_SCOPE_AGENT
#define LDS_WAIT() asm volatile("s_waitcnt lgkmcnt(0)" ::: "memory")
#define VM_WAIT() asm volatile("s_waitcnt vmcnt(0)" ::: "memory")
__device__ __forceinline__ unsigned f2bf(float f) { unsigned u = __builtin_bit_cast(unsigned, f); return (u + 0x7fffu + ((u >> 16) & 1u)) >> 16; }
__device__ __forceinline__ unsigned pk2(float lo, float hi) { return f2bf(lo) | (f2bf(hi) << 16); }
__device__ __forceinline__ float bflo(unsigned w) { return __builtin_bit_cast(float, w << 16); }
__device__ __forceinline__ float bfhi(unsigned w) { return __builtin_bit_cast(float, w & 0xffff0000u); }
__device__ __forceinline__ float bf2f(bf16 b) { return __builtin_bit_cast(float, (unsigned)b << 16); }
__device__ __forceinline__ float wave_sum(float v) {
#pragma unroll
    for (int o = 1; o < 64; o <<= 1) v += __shfl_xor(v, o);
    return v;
}
__device__ __forceinline__ float wave_max(float v) {
#pragma unroll
    for (int o = 1; o < 64; o <<= 1) v = fmaxf(v, __shfl_xor(v, o));
    return v;
}
__device__ __forceinline__ float gelu_tanh(float x) {
    const float z = 0.7978845608028654f * (x + 0.044715f * x * x * x);
    return x / (1.0f + __builtin_amdgcn_exp2f(-2.0f * LOG2E * z));
}
__device__ __forceinline__ float sigmoidf_(float x) { return 1.0f / (1.0f + __builtin_amdgcn_exp2f(-LOG2E * x)); }

namespace pg8 {
#define PG8_LAS __attribute__((address_space(3)))
typedef unsigned short bf16_t;
typedef short bf16x8 __attribute__((ext_vector_type(8)));
typedef float f32x4 __attribute__((ext_vector_type(4)));
typedef unsigned u32x4 __attribute__((ext_vector_type(4)));
constexpr int BM = 256, BK = 64, HALF = 128, HTB = HALF * BK * 2  , STAGE_BYTES = 8 * HTB, NXCD = 8, WGM = 8;

__host__ __device__ __forceinline__ int lds_byte(int r, int c) { const int st = (r >> 4) * 2 + (c >> 5), rr = r & 15, cc = c & 31, ob = rr * 64 + cc * 2; return st * 1024 + (ob ^ (((ob >> 9) & 1) << 5)); }
__host__ __device__ __forceinline__ void stage_rc(int b, int& R, int& C) { const int st = b / 1024, sb = b % 1024, swz = sb ^ (((sb >> 9) & 1) << 5); R = (st >> 1) * 16 + swz / 64; C = (st & 1) * 32 + (swz % 64) / 2; }
__host__ __device__ __forceinline__ int perm32(int rho) { const int n = rho >> 4, i = rho & 15; return 8 * (i >> 2) + 4 * n + (i & 3); }

struct Unit { int pm, pn; };
struct Gemm { const bf16_t* A; const bf16_t* Bt; int M, N, K; };

struct StaticOrder {
    int nM, nN, nwg, G, c;
    __host__ __device__ void init(int M, int N, int G_, int c_) { nM = M / BM; nN = N / BM; nwg = nM * nN; G = G_; c = c_; }
    __host__ __device__ bool next(int i, Unit& u) const {
        const long L = (long)i * G + c; if (L >= nwg) return false;
        int wgid = (int)L; { const int q = nwg / NXCD, r = nwg % NXCD, xcd = wgid % NXCD, off = wgid / NXCD; wgid = (xcd < r ? xcd * (q + 1) : r * (q + 1) + (xcd - r) * q) + off; }
        const int nig = WGM * nN, gid = wgid / nig, fm = gid * WGM, gsz = (nM - fm) < WGM ? (nM - fm) : WGM;
        u.pm = fm + ((wgid % nig) % gsz); u.pn = (wgid % nig) / gsz; return true;
    }
    __device__ __forceinline__ void a_ready(const Unit&) const {}
    __device__ __forceinline__ void done(const Unit&) const {}
};

__device__ __forceinline__ unsigned cvt_pk_bf16(float lo, float hi) { unsigned r; asm volatile("v_cvt_pk_bf16_f32 %0, %1, %2" : "=v"(r) : "v"(lo), "v"(hi)); return r; }

typedef unsigned u32x2 __attribute__((ext_vector_type(2)));
constexpr int E_NROW_P = 32768, E_NROW = 33792, E_KVS = 4224;
constexpr float E_EPS = 1e-6f, E_QSCALE = 0.125f * 1.4426950408889634f;

struct EpiInProj {
    static constexpr bool PERM = true, AFTER_DRAIN = false, MIDSCALE = false;
    bf16_t *Q, *Kp, *Vp, *Ks, *Vs, *U, *Us; const float *gq, *gk;
    __device__ __forceinline__ void mid(f32x4 (&)[2][2][4][2], const Unit&, int, int) const {}
    __device__ __forceinline__ void operator()(const f32x4 (&acc)[2][2][4][2], const Unit& u, int wr, int wc, int fr, int fq) const {
        const int pn = u.pn, pm = u.pm;
        if (pn <= 2) {
            const bool isq = pn < 2, isk = (pn == 2) && (wc < 2), normed = isq || isk;
            const float* gp = isq ? gq : gk;
            f32x4 gv[2][2];
#pragma unroll
            for (int bj = 0; bj < 2; ++bj)
#pragma unroll
                for (int n = 0; n < 2; ++n) { f32x4 g = normed ? *(const f32x4*)(gp + 32 * bj + 8 * fq + 4 * n) : (f32x4){1.f, 1.f, 1.f, 1.f}; if (isq) g = g * E_QSCALE; gv[bj][n] = g; }
#pragma unroll
            for (int ai = 0; ai < 2; ++ai)
#pragma unroll
                for (int m = 0; m < 4; ++m) {
                    const int r = pm * BM + ai * HALF + wr * 64 + m * 16 + fr;
                    f32x4 v[2][2]; float ss = 0.f;
#pragma unroll
                    for (int bj = 0; bj < 2; ++bj)
#pragma unroll
                        for (int n = 0; n < 2; ++n) { v[bj][n] = acc[ai][bj][m][n]; const f32x4 x = v[bj][n]; ss += (x[0] * x[0] + x[1] * x[1]) + (x[2] * x[2] + x[3] * x[3]); }
                    float rs = 1.f;
                    if (normed) { ss += __shfl_xor(ss, 16); ss += __shfl_xor(ss, 32); rs = rsqrtf(ss * (1.0f / 64.0f) + E_EPS); }
                    u32x4 w[2];
#pragma unroll
                    for (int bj = 0; bj < 2; ++bj) { const f32x4 a = v[bj][0] * gv[bj][0] * rs, b = v[bj][1] * gv[bj][1] * rs;
                        w[bj].x = cvt_pk_bf16(a[0], a[1]); w[bj].y = cvt_pk_bf16(a[2], a[3]); w[bj].z = cvt_pk_bf16(b[0], b[1]); w[bj].w = cvt_pk_bf16(b[2], b[3]); }
                    if (isq) {
                        bf16_t* d = Q + (size_t)r * 512 + (4 * pn + wc) * 64 + 8 * fq;
                        *(u32x4*)(d) = w[0]; *(u32x4*)(d + 32) = w[1];
                    } else {
                        const int col = (wc & 1) * 64 + 8 * fq;
                        bf16_t* basep = isk ? Kp : Vp; bf16_t* bases = isk ? Ks : Vs;
                        if (pm < 128) { bf16_t* d = basep + (size_t)((pm >> 4) * E_KVS + 128 + (r & 4095)) * 128 + col; *(u32x4*)(d) = w[0]; *(u32x4*)(d + 32) = w[1]; }
                        else if (pm < 132) { bf16_t* d = bases + (size_t)(r - E_NROW_P) * 128 + col; *(u32x4*)(d) = w[0]; *(u32x4*)(d + 32) = w[1]; }
                        else { const int j = r - E_NROW; if (j < 16) {
#pragma unroll
                            for (int b = 0; b < 8; ++b) { bf16_t* d = basep + (size_t)(b * E_KVS + 112 + j) * 128 + col; *(u32x4*)(d) = w[0]; *(u32x4*)(d + 32) = w[1]; } } }
                    }
                }
        } else {
#pragma unroll
            for (int ai = 0; ai < 2; ++ai)
#pragma unroll
                for (int m = 0; m < 4; ++m) {
                    const int r = pm * BM + ai * HALF + wr * 64 + m * 16 + fr;
#pragma unroll
                    for (int bj = 0; bj < 2; ++bj) {
                        const f32x4 a = acc[ai][bj][m][0], b = acc[ai][bj][m][1];
                        u32x4 w; w.x = cvt_pk_bf16(a[0], a[1]); w.y = cvt_pk_bf16(a[2], a[3]); w.z = cvt_pk_bf16(b[0], b[1]); w.w = cvt_pk_bf16(b[2], b[3]);
                        const int g = 16 * (pn - 3) + 8 * bj + 2 * wc + (fq >> 1), ch = 8 * (fq & 1);
                        if (pm < 128) { *(u32x4*)(U + ((size_t)(g * 8 + (pm >> 4)) * E_KVS + 128 + (r & 4095)) * 16 + ch) = w; }
                        else if (pm < 132) { *(u32x4*)(Us + ((size_t)g * 1024 + (r - E_NROW_P)) * 16 + ch) = w; }
                        else { const int j = r - E_NROW; if (j < 16) {
#pragma unroll
                            for (int b2 = 0; b2 < 8; ++b2) *(u32x4*)(U + ((size_t)(g * 8 + b2) * E_KVS + 112 + j) * 16 + ch) = w; } }
                    }
                }
        }
    }
};

struct EpiOutProj {
    static constexpr bool PERM = false, AFTER_DRAIN = false, MIDSCALE = true;
    const float *xp, *xs; float* out; bf16_t* HB; const float *ssq_ssm, *ssq_att; float* ssq_h;
    __device__ __forceinline__ void mid(f32x4 (&acc)[2][2][4][2], const Unit& u, int wr, int fr) const {
        asm volatile("" : "+v"(fr));
#pragma unroll
        for (int ai = 0; ai < 2; ++ai)
#pragma unroll
            for (int m = 0; m < 4; ++m) {
                const int r = u.pm * BM + ai * HALF + wr * 64 + m * 16 + fr;
                const float ratio = sqrtf((ssq_att[r] * (1.0f / 512.0f) + E_EPS) / (ssq_ssm[r] * (1.0f / 512.0f) + E_EPS));
#pragma unroll
                for (int bj = 0; bj < 2; ++bj)
#pragma unroll
                    for (int n = 0; n < 2; ++n) acc[ai][bj][m][n] = acc[ai][bj][m][n] * ratio;
            }
    }
    __device__ __forceinline__ void operator()(const f32x4 (&acc)[2][2][4][2], const Unit& u, int wr, int wc, int fr, int fq) const {
        asm volatile("" : "+v"(fr), "+v"(fq));
        const int col0 = u.pn * BM + wc * 32 + 4 * fq;
#pragma unroll
        for (int ai = 0; ai < 2; ++ai)
#pragma unroll
            for (int m = 0; m < 4; ++m) {
                const int r = u.pm * BM + ai * HALF + wr * 64 + m * 16 + fr;
                const float ra = rsqrtf(ssq_att[r] * (1.0f / 512.0f) + E_EPS);
                const float* xrow = (r < E_NROW_P) ? xp + (size_t)r * 1024 : xs + (size_t)(r - E_NROW_P) * 1024;
                float s = 0.f;
#pragma unroll
                for (int bj = 0; bj < 2; ++bj)
#pragma unroll
                    for (int n = 0; n < 2; ++n) {
                        const int c = col0 + bj * HALF + n * 16;
                        const f32x4 h = *(const f32x4*)(xrow + c) + acc[ai][bj][m][n] * ra;
                        *(f32x4*)(out + (size_t)r * 1024 + c) = h;
                        u32x2 w; w.x = cvt_pk_bf16(h[0], h[1]); w.y = cvt_pk_bf16(h[2], h[3]);
                        *(u32x2*)(HB + (size_t)r * 1024 + c) = w;
                        s += (h[0] * h[0] + h[1] * h[1]) + (h[2] * h[2] + h[3] * h[3]);
                    }
                s += __shfl_xor(s, 16); s += __shfl_xor(s, 32);
                if (fq == 0) atomicAdd(ssq_h + r, s);
            }
    }
};

struct EpiGateUp {
    static constexpr bool PERM = true, AFTER_DRAIN = false, MIDSCALE = false;
    bf16_t* HFF; const float* ssq_h;
    __device__ __forceinline__ void mid(f32x4 (&)[2][2][4][2], const Unit&, int, int) const {}
    __device__ __forceinline__ void operator()(const f32x4 (&acc)[2][2][4][2], const Unit& u, int wr, int wc, int fr, int fq) const {
        const int col0 = u.pn * HALF + wc * 32 + 8 * fq;
#pragma unroll
        for (int ai = 0; ai < 2; ++ai)
#pragma unroll
            for (int m = 0; m < 4; ++m) {
                const int r = u.pm * BM + ai * HALF + wr * 64 + m * 16 + fr;
                const float rs = rsqrtf(ssq_h[r] * (1.0f / 1024.0f) + E_EPS);
                float o[8];
#pragma unroll
                for (int n = 0; n < 2; ++n)
#pragma unroll
                    for (int e = 0; e < 4; ++e) { const float g = acc[ai][0][m][n][e] * rs, up = acc[ai][1][m][n][e] * rs;
                        o[4 * n + e] = g * __builtin_amdgcn_rcpf(1.0f + __builtin_amdgcn_exp2f(-1.4426950408889634f * g)) * up; }
                u32x4 w; w.x = cvt_pk_bf16(o[0], o[1]); w.y = cvt_pk_bf16(o[2], o[3]); w.z = cvt_pk_bf16(o[4], o[5]); w.w = cvt_pk_bf16(o[6], o[7]);
                *(u32x4*)(HFF + (size_t)r * 2816 + col0) = w;
            }
    }
};

struct EpiDown {
    static constexpr bool PERM = false, AFTER_DRAIN = false, MIDSCALE = false;
    float* out;
    __device__ __forceinline__ void mid(f32x4 (&)[2][2][4][2], const Unit&, int, int) const {}
    __device__ __forceinline__ void operator()(const f32x4 (&acc)[2][2][4][2], const Unit& u, int wr, int wc, int fr, int fq) const {
        const int col0 = u.pn * BM + wc * 32 + 4 * fq;
#pragma unroll
        for (int ai = 0; ai < 2; ++ai)
#pragma unroll
            for (int m = 0; m < 4; ++m) {
                float* rowp = out + (size_t)(u.pm * BM + ai * HALF + wr * 64 + m * 16 + fr) * 1024 + col0;
#pragma unroll
                for (int bj = 0; bj < 2; ++bj)
#pragma unroll
                    for (int n = 0; n < 2; ++n) { float* p = rowp + bj * HALF + n * 16; *(f32x4*)p = *(const f32x4*)p + acc[ai][bj][m][n]; }
            }
    }
};

template <class Epi, class Sched, bool ALIGN_EPI = false, bool SP2 = false>
__device__ __forceinline__ void gemm_phase(PG8_LAS unsigned char* lds, const Gemm g, const Sched& S, const Epi& E) {
    const int tid = threadIdx.x, wid = __builtin_amdgcn_readfirstlane(tid >> 6), lane = tid & 63, wr = wid >> 2, wc = wid & 3, fr = lane & 15, fq = lane >> 4;
    const int K = g.K, nt = K / BK;
    unsigned voffA[2], voffB[2];
#pragma unroll
    for (int i = 0; i < 2; ++i) { int R, C; stage_rc(tid * 16 + i * 8192, R, C); const int Rb = Epi::PERM ? ((R & ~31) + perm32(R & 31)) : R;
        voffA[i] = (unsigned)(R * K + C) * 2u; voffB[i] = (unsigned)(Rb * K + C) * 2u; }
    const size_t kstep = (size_t)(BK * 2);
    const size_t hstep = (size_t)HALF * K * 2;
    const size_t tstep = 2 * hstep;
    const unsigned ldsw = (unsigned)wid * 1024u;
    const int aoff = lds_byte(wr * 64 + fr, fq * 8), boff = lds_byte(wc * 32 + fr, fq * 8);
#define PG8_SA(b, h) (((b) * 2 + (h)) * HTB)
#define PG8_SB(b, h) ((4 + (b) * 2 + (h)) * HTB)
#define PG8_STAGE(bufoff, gbase, voff) do { _Pragma("unroll") for (int _i = 0; _i < 2; ++_i) \
        __builtin_amdgcn_global_load_lds((const unsigned*)((const char*)(gbase) + (voff)[_i]), (PG8_LAS unsigned*)(lds + (bufoff) + ldsw + _i * 8192), 16, 0, 0); } while (0)
#define PG8_LDA(dst, b, h) do { _Pragma("unroll") for (int m = 0; m < 4; ++m) _Pragma("unroll") for (int k = 0; k < 2; ++k) dst[m][k] = *(const PG8_LAS bf16x8*)(lds + PG8_SA(b, h) + aoff + m * 2048 + k * 1024); } while (0)
#define PG8_LDB(dst, b, h) do { _Pragma("unroll") for (int n = 0; n < 2; ++n) _Pragma("unroll") for (int k = 0; k < 2; ++k) dst[n][k] = *(const PG8_LAS bf16x8*)(lds + PG8_SB(b, h) + boff + n * 2048 + k * 1024); } while (0)
#define PG8_MMA(ai, bj, At, Bt) do { __builtin_amdgcn_s_setprio(1); _Pragma("unroll") for (int m = 0; m < 4; ++m) _Pragma("unroll") for (int n = 0; n < 2; ++n) _Pragma("unroll") for (int k = 0; k < 2; ++k) \
        acc[ai][bj][m][n] = __builtin_amdgcn_mfma_f32_16x16x32_bf16(Bt[n][k], At[m][k], acc[ai][bj][m][n], 0, 0, 0); __builtin_amdgcn_s_setprio(0); } while (0)
#define PG8_WAIT_V(n) asm volatile("s_waitcnt vmcnt(" #n ")" ::: "memory")
#define PG8_WAIT_L(n) asm volatile("s_waitcnt lgkmcnt(" #n ")" ::: "memory")
#define PG8_BAR __builtin_amdgcn_s_barrier()
#define PG8_SCHED __builtin_amdgcn_sched_barrier(0)
    Unit cur, nxt; int ui = 0;
    if (!S.next(0, cur)) return;
    f32x4 acc[2][2][4][2];
#pragma unroll
    for (int a = 0; a < 2; ++a)
#pragma unroll
        for (int b = 0; b < 2; ++b)
#pragma unroll
            for (int m = 0; m < 4; ++m)
#pragma unroll
                for (int n = 0; n < 2; ++n) acc[a][b][m][n] = (f32x4){0.f, 0.f, 0.f, 0.f};
    bf16x8 At[4][2], B0[2][2], B1[2][2];
    const char* cA = (const char*)g.A + (size_t)cur.pm * tstep; const char* cB = (const char*)g.Bt + (size_t)cur.pn * tstep;
    S.a_ready(cur);
    if constexpr (SP2) {
        PG8_STAGE(PG8_SB(0, 0), cB, voffB); PG8_STAGE(PG8_SB(0, 1), cB + hstep, voffB); PG8_STAGE(PG8_SA(0, 0), cA, voffA); PG8_STAGE(PG8_SA(0, 1), cA + hstep, voffA);
        if (wr == 1) PG8_BAR;
        PG8_WAIT_V(2); PG8_BAR;
        PG8_STAGE(PG8_SB(1, 0), cB + kstep, voffB); PG8_STAGE(PG8_SA(1, 0), cA + kstep, voffA); PG8_STAGE(PG8_SB(1, 1), cB + hstep + kstep, voffB);
        PG8_WAIT_V(6); PG8_BAR;
    } else {
        PG8_STAGE(PG8_SB(0, 0), cB, voffB); PG8_STAGE(PG8_SA(0, 0), cA, voffA); PG8_STAGE(PG8_SB(0, 1), cB + hstep, voffB); PG8_STAGE(PG8_SA(0, 1), cA + hstep, voffA);
        if (wr == 1) PG8_BAR;
        PG8_WAIT_V(4); PG8_BAR;
        PG8_STAGE(PG8_SB(1, 0), cB + kstep, voffB); PG8_STAGE(PG8_SA(1, 0), cA + kstep, voffA); PG8_STAGE(PG8_SB(1, 1), cB + hstep + kstep, voffB);
        PG8_WAIT_V(6); PG8_BAR;
    }
    for (;;) {
        const bool has_next = S.next(ui + 1, nxt);
        const char* nA = has_next ? (const char*)g.A + (size_t)nxt.pm * tstep : cA; const char* nB = has_next ? (const char*)g.Bt + (size_t)nxt.pn * tstep : cB;
        for (int t = 0; t < nt; t += 2) {
            if constexpr (Epi::MIDSCALE) { if (t == (nt >> 1)) E.mid(acc, cur, wr, fr); }
            const bool last = (t == nt - 2);
            const char* a1 = cA + (size_t)(t + 1) * kstep;
            const char* a2 = last ? nA : cA + (size_t)(t + 2) * kstep; const char* b2 = last ? nB : cB + (size_t)(t + 2) * kstep;
            const char* a3 = a2 + kstep; const char* b3 = b2 + kstep;
            if (last && has_next) S.a_ready(nxt);
            if constexpr (SP2) {
            PG8_LDB(B0, 0, 0); PG8_LDB(B1, 0, 1); PG8_SCHED; PG8_LDA(At, 0, 0); PG8_STAGE(PG8_SA(1, 1), a1 + hstep, voffA);
            PG8_WAIT_V(8); PG8_WAIT_L(0); PG8_BAR; PG8_MMA(0, 0, At, B0); PG8_MMA(0, 1, At, B1); PG8_BAR; PG8_SCHED;
            PG8_LDA(At, 0, 1); PG8_STAGE(PG8_SB(0, 0), b2, voffB); PG8_STAGE(PG8_SB(0, 1), b2 + hstep, voffB); PG8_STAGE(PG8_SA(0, 0), a2, voffA);
            PG8_WAIT_V(8); PG8_WAIT_L(0); PG8_BAR; PG8_MMA(1, 0, At, B0); PG8_MMA(1, 1, At, B1); PG8_BAR; PG8_SCHED;
            PG8_LDB(B0, 1, 0); PG8_LDB(B1, 1, 1); PG8_SCHED; PG8_LDA(At, 1, 0); PG8_STAGE(PG8_SA(0, 1), a2 + hstep, voffA);
            PG8_WAIT_V(8); PG8_WAIT_L(0); PG8_BAR; PG8_MMA(0, 0, At, B0); PG8_MMA(0, 1, At, B1); PG8_BAR; PG8_SCHED;
            PG8_LDA(At, 1, 1); PG8_STAGE(PG8_SB(1, 0), b3, voffB); PG8_STAGE(PG8_SB(1, 1), b3 + hstep, voffB); PG8_STAGE(PG8_SA(1, 0), a3, voffA);
            PG8_WAIT_V(8); PG8_WAIT_L(0); PG8_BAR; PG8_MMA(1, 0, At, B0); PG8_MMA(1, 1, At, B1); PG8_BAR; PG8_SCHED;
            } else {
            PG8_LDB(B0, 0, 0); PG8_SCHED; PG8_LDA(At, 0, 0); PG8_STAGE(PG8_SA(1, 1), a1 + hstep, voffA);
            PG8_WAIT_L(8); PG8_BAR; PG8_WAIT_L(0); PG8_MMA(0, 0, At, B0); PG8_BAR; PG8_SCHED;
            PG8_LDB(B1, 0, 1); PG8_STAGE(PG8_SB(0, 0), b2, voffB);
            PG8_BAR; PG8_WAIT_L(0); PG8_MMA(0, 1, At, B1); PG8_BAR;
            PG8_LDA(At, 0, 1); PG8_STAGE(PG8_SA(0, 0), a2, voffA);
            PG8_BAR; PG8_WAIT_L(0); PG8_MMA(1, 0, At, B0); PG8_BAR; PG8_SCHED;
            PG8_STAGE(PG8_SB(0, 1), b2 + hstep, voffB);
            PG8_WAIT_V(6); PG8_BAR; PG8_MMA(1, 1, At, B1); PG8_BAR;
            PG8_LDB(B0, 1, 0); PG8_SCHED; PG8_LDA(At, 1, 0); PG8_STAGE(PG8_SA(0, 1), a2 + hstep, voffA);
            PG8_WAIT_L(8); PG8_BAR; PG8_WAIT_L(0); PG8_MMA(0, 0, At, B0); PG8_BAR; PG8_SCHED;
            PG8_LDB(B1, 1, 1); PG8_STAGE(PG8_SB(1, 0), b3, voffB);
            PG8_BAR; PG8_WAIT_L(0); PG8_MMA(0, 1, At, B1); PG8_BAR;
            PG8_LDA(At, 1, 1); PG8_STAGE(PG8_SA(1, 0), a3, voffA);
            PG8_BAR; PG8_WAIT_L(0); PG8_MMA(1, 0, At, B0); PG8_BAR; PG8_SCHED;
            PG8_STAGE(PG8_SB(1, 1), b3 + hstep, voffB);
            PG8_WAIT_V(6); PG8_BAR; PG8_MMA(1, 1, At, B1); PG8_BAR;
            }
        }
        if constexpr (ALIGN_EPI) { if (wr == 0) PG8_BAR; }
        if constexpr (!Epi::AFTER_DRAIN) { E(acc, cur, wr, wc, fr, fq); S.done(cur); }
        if (!has_next) break;
#pragma unroll
        for (int a = 0; a < 2; ++a)
#pragma unroll
            for (int b = 0; b < 2; ++b)
#pragma unroll
                for (int m = 0; m < 4; ++m)
#pragma unroll
                    for (int n = 0; n < 2; ++n) acc[a][b][m][n] = (f32x4){0.f, 0.f, 0.f, 0.f};
        cur = nxt; cA = nA; cB = nB; ++ui;
        if constexpr (ALIGN_EPI) { if (wr == 1) PG8_BAR; }
    }
    PG8_WAIT_V(0);
    if constexpr (!ALIGN_EPI) { if (wr == 0) PG8_BAR; }
    PG8_BAR;
    if constexpr (Epi::AFTER_DRAIN) { E.fused(acc, cur, wr, wc, fr, fq, lds, wid, lane); S.done(cur); }
#undef PG8_SA
#undef PG8_SB
#undef PG8_STAGE
#undef PG8_LDA
#undef PG8_LDB
#undef PG8_MMA
#undef PG8_WAIT_V
#undef PG8_WAIT_L
#undef PG8_BAR
#undef PG8_SCHED
}
}


#ifndef PG8_SP2
#define PG8_SP2 true
#endif
#ifndef PG8_ALIGN
#define PG8_ALIGN true
#endif
constexpr int N_LAUNCHES = MK_N_LAUNCHES;
constexpr int PER_PHASE = 6;
constexpr int CW_TMO = 0, CW_CODE = 1;
constexpr int CW_BAR = 4096;

#define XB_TMO      128
#define XB_XCNT(j)  (256  + 64 * (j))
#define XB_XSUB(j)  (1280 + 64 * (j))
#define XB_XGEN(j)  (2304 + 64 * (j))
#define XB_TOP      3328
#define XB_TOPGEN   3392
#define XCD_BAR_WORDS 3456
#define XB_SPIN_CAP (1u << 18)

__device__ __forceinline__ unsigned xb_ld(unsigned* p)              { return __hip_atomic_load(p, __ATOMIC_RELAXED, __HIP_MEMORY_SCOPE_AGENT); }
__device__ __forceinline__ unsigned xb_add(unsigned* p, unsigned v) { return __hip_atomic_fetch_add(p, v, __ATOMIC_RELAXED, __HIP_MEMORY_SCOPE_AGENT); }
__device__ __forceinline__ unsigned xb_xcc_id() { return (unsigned)__builtin_amdgcn_s_getreg((3 << 11) | 20) & 0xFu; }
#define XB_SPIN(cond, bar) do { unsigned _sp = 0; while (cond) { __builtin_amdgcn_s_sleep(1); \
    if ((++_sp & 255u) == 0u) { if (xb_ld(&(bar)[XB_TMO])) break; if (_sp > XB_SPIN_CAP) { atomicAdd(&(bar)[XB_TMO], 1u); break; } } } } while (0)

struct XcdBarrier {
    unsigned* bar; unsigned x;
    volatile LAS unsigned* st;
};

__device__ __forceinline__ XcdBarrier xcd_barrier_post(unsigned* bar, volatile LAS unsigned* st) {
    XcdBarrier b; b.bar = bar; b.x = xb_xcc_id(); b.st = st;
    if (threadIdx.x == 0) (void)xb_add(&bar[XB_XCNT(b.x)], 1u);
    return b;
}
__device__ __forceinline__ void xcd_barrier_complete(unsigned* bar, unsigned x, unsigned& nloc, unsigned& nx) {
    const unsigned G = gridDim.x * gridDim.y * gridDim.z;
    unsigned sum, cnt, mine, sp = 0u;
    for (;;) {
        sum = 0u; cnt = 0u; mine = 0u;
#pragma unroll
        for (unsigned j = 0; j < 16; ++j) { const unsigned c = xb_ld(&bar[XB_XCNT(j)]); sum += c; cnt += (c > 0u) ? 1u : 0u; mine = (j == x) ? c : mine; }
        if (sum == G) break;
        __builtin_amdgcn_s_sleep(1);
        if ((++sp & 255u) == 0u) { if (xb_ld(&bar[XB_TMO])) break; if (sp > XB_SPIN_CAP) { atomicAdd(&bar[XB_TMO], 1u); break; } }
    }
    nloc = mine > 0u ? mine : 1u; nx = cnt > 0u ? cnt : 1u;
}

__device__ __forceinline__ void xcd_barrier(const XcdBarrier& b) {
    asm volatile("s_waitcnt vmcnt(0)" ::: "memory");
    __syncthreads();
    if (threadIdx.x == 0) {
        unsigned* bar = b.bar;
        __builtin_amdgcn_s_waitcnt(0);
        unsigned nloc = b.st[0], nx = b.st[1];
        if (nloc == 0u) { xcd_barrier_complete(bar, b.x, nloc, nx); b.st[0] = nloc; b.st[1] = nx; }
        const unsigned old = xb_add(&bar[XB_XSUB(b.x)], 1u);
        const unsigned gen = old / nloc;
        if (old + 1u == (gen + 1u) * nloc) {
            __builtin_amdgcn_fence(__ATOMIC_RELEASE, "agent");
            asm volatile("s_waitcnt vmcnt(0)" ::: "memory");
            const unsigned og = xb_add(&bar[XB_TOP], 1u);
            const unsigned tg = og / nx;
            if (og + 1u == (tg + 1u) * nx) xb_add(&bar[XB_TOPGEN], 1u);
            else XB_SPIN(xb_ld(&bar[XB_TOPGEN]) == tg, bar);
            __builtin_amdgcn_fence(__ATOMIC_ACQUIRE, "agent");
            xb_add(&bar[XB_XGEN(b.x)], 1u);
            asm volatile("s_waitcnt vmcnt(0)" ::: "memory");
        } else {
            XB_SPIN(xb_ld(&bar[XB_XGEN(b.x)]) == gen, bar);
            __builtin_amdgcn_fence(__ATOMIC_ACQUIRE, "agent");
            asm volatile("s_waitcnt vmcnt(0)" ::: "memory");
        }
    }
    __syncthreads();
}


struct Frame {
    LAS unsigned char* lds;
    volatile LAS unsigned* MISC;
    gu32* ctl;
    int tid, lane, wave;
    int vcu, G;
    const float* in[29];
    float* out;
    unsigned char* ws;
};
#define WSP(T, off) ((T*)(F.ws + (off)))

__device__ __forceinline__ void tr_item(const float* W, int ldw, int src_k0, int src_n0, const float* kscale, bf16* WT, int ldwt, int dst_n0, int dst_k0, LAS float* scr, int lane) {
#pragma unroll 8
    for (int i = 0; i < 32; ++i) { const int kk = 2 * i + (lane >> 5); float v = W[(size_t)(src_k0 + kk) * ldw + src_n0 + (lane & 31)]; if (kscale) v *= kscale[kk]; scr[kk * 33 + (lane & 31)] = v; }
    LDS_WAIT(); asm volatile("" ::: "memory");
    const int c = lane & 7;
#pragma unroll
    for (int j = 0; j < 4; ++j) { const int n = (lane >> 3) + 8 * j; const LAS float* s = scr + (8 * c) * 33 + n;
        v4u o; o.x = pk2(s[0 * 33], s[1 * 33]); o.y = pk2(s[2 * 33], s[3 * 33]); o.z = pk2(s[4 * 33], s[5 * 33]); o.w = pk2(s[6 * 33], s[7 * 33]);
        *(GAS v4u*)(WT + (size_t)(dst_n0 + n) * ldwt + dst_k0 + 8 * c) = o; }
    LDS_WAIT(); asm volatile("" ::: "memory");
}
__device__ __forceinline__ void p0_prologue(Frame& F) {
    LAS float* scr = (LAS float*)(F.lds + RING_OFF + F.wave * 16384);
    const int gw = F.vcu * NWAVES + F.wave, NGW = F.G * NWAVES, lane = F.lane;
    constexpr int I_IN = 16 * 40, I_O = 16 * 32, I_GU = 16 * 176, I_D = 44 * 32, NITEMS = I_IN + I_O + I_GU + I_D;
    for (int it = gw; it < NITEMS; it += NGW) {
        int r = it;
        if (r < I_IN) { const int kb = r / 40, nb = r % 40, n0 = 32 * nb; int s0 = n0;
            if (n0 < 768) { const int pn = n0 >> 8, ct = n0 & 255; s0 = 256 * pn + 64 * ((ct & 127) >> 5) + 32 * (ct >> 7); }
            tr_item(F.in[8], INC, 64 * kb, s0, nullptr, WSP(bf16, WS_WIN), DM, n0, 64 * kb, scr, lane); continue; }
        r -= I_IN;
        if (r < I_O) { const int kb = r / 32, nb = r % 32, k0 = 64 * kb;
            const int sk = k0 < 512 ? k0 + 512 : k0 - 512; const float* ks = k0 < 512 ? F.in[23] + k0 : F.in[22] + (k0 - 512);
            tr_item(F.in[24], DM, sk, 32 * nb, ks, WSP(bf16, WS_WO), DM, 32 * nb, k0, scr, lane); continue; }
        r -= I_O;
        if (r < I_GU) { const int kb = r / 176, nb = r % 176, n0 = 32 * nb, pn = n0 >> 8, ct = n0 & 255;
            const float* W = ct < 128 ? F.in[26] : F.in[27];
            tr_item(W, DFF, 64 * kb, 128 * pn + (ct & 127), F.in[25] + 64 * kb, WSP(bf16, WS_WGU), DM, n0, 64 * kb, scr, lane); continue; }
        r -= I_GU;
        { const int kb = r / 32, nb = r % 32; tr_item(F.in[28], DM, 64 * kb, 32 * nb, nullptr, WSP(bf16, WS_WD), DFF, 32 * nb, 64 * kb, scr, lane); }
    }
    {
        const GAS v4f* gp = (const GAS v4f*)F.in[7] + lane;
        v4f g[4];
#pragma unroll
        for (int j = 0; j < 4; ++j) g[j] = gp[64 * j];
        bf16* XN = WSP(bf16, WS_XN);
        for (int r = gw; r < NROW_IN; r += NGW) {
            GAS unsigned long long* o8 = (GAS unsigned long long*)(XN + (size_t)r * DM) + lane;
            if (r >= ROW_META + NMETA) {
#pragma unroll
                for (int j = 0; j < 4; ++j) o8[64 * j] = 0ull;
                continue;
            }
            const float* xrow = r < NROW_P ? F.in[0] + (size_t)r * DM : (r < NROW ? F.in[1] + (size_t)(r - NROW_P) * DM : F.in[6] + (size_t)(r - NROW) * DM);
            const GAS v4f* xr = (const GAS v4f*)xrow + lane;
            v4f v[4]; float s = 0.f;
#pragma unroll
            for (int j = 0; j < 4; ++j) { v[j] = xr[64 * j]; s += (v[j].x * v[j].x + v[j].y * v[j].y) + (v[j].z * v[j].z + v[j].w * v[j].w); }
            const float rstd = rsqrtf(wave_sum(s) * (1.f / DM) + EPS);
#pragma unroll
            for (int j = 0; j < 4; ++j) { const v4f y = v[j] * g[j] * rstd; o8[64 * j] = (unsigned long long)pk2(y.x, y.y) | ((unsigned long long)pk2(y.z, y.w) << 32); }
        }
    }
    {
        const int gt = gw * 64 + lane, NT = NGW * 64;
        GAS v4f* ssq = (GAS v4f*)WSP(float, WS_SSQ);
        for (int i = gt; i < 3 * NROW / 4; i += NT) ssq[i] = (v4f){0.f, 0.f, 0.f, 0.f};
        for (int i = gt; i < 256 * 224; i += NT) { const int gb = i / 224, w = i % 224; *(GAS v4u*)(F.ws + WS_U + (size_t)gb * KVS * 32 + (size_t)w * 16) = (v4u){0u, 0u, 0u, 0u}; }
        for (int i = gt; i < 8 * 1792; i += NT) { const int b = i / 1792, w = i % 1792;
            *(GAS v4u*)(F.ws + WS_KP + (size_t)b * KVS * 256 + (size_t)w * 16) = (v4u){0u, 0u, 0u, 0u}; *(GAS v4u*)(F.ws + WS_VP + (size_t)b * KVS * 256 + (size_t)w * 16) = (v4u){0u, 0u, 0u, 0u}; }
        for (int i = gt; i < DECB * 3840; i += NT) { const int db = i / 3840, w = i % 3840;
            ((GAS v4f*)(F.out + O_KWS + (size_t)db * 16384))[w] = ((const GAS v4f*)(F.in[2] + (size_t)db * 16384 + 1024))[w];
            ((GAS v4f*)(F.out + O_VWS + (size_t)db * 16384))[w] = ((const GAS v4f*)(F.in[3] + (size_t)db * 16384 + 1024))[w]; }
    }
}

__device__ __forceinline__ void unpack8(const v4u w, float* f) { f[0] = bflo(w.x); f[1] = bfhi(w.x); f[2] = bflo(w.y); f[3] = bfhi(w.y); f[4] = bflo(w.z); f[5] = bfhi(w.z); f[6] = bflo(w.w); f[7] = bfhi(w.w); }
__device__ __forceinline__ void p2_simple_attn(Frame& F) {
    LAS float* pw = (LAS float*)(F.lds + RING_OFF) + F.wave * 192;
    const int gw = F.vcu * NWAVES + F.wave, NGW = F.G * NWAVES, lane = F.lane;
    const bf16 *Q = WSP(bf16, WS_Q), *Kp = WSP(bf16, WS_KP), *Vp = WSP(bf16, WS_VP), *Ks = WSP(bf16, WS_KS), *Vs = WSP(bf16, WS_VS);
    bf16* MIX = WSP(bf16, WS_MIX); float* ssq_att = WSP(float, WS_SSQ) + NROW;
    const float *ck = F.in[2], *cv = F.in[3];
    for (int it = gw; it < NROW * NHQ; it += NGW) {
        const int r = it >> 3, h = it & 7, kvh = h >> 2;
        float q[64];
        { const v4u* qp = (const v4u*)(Q + (size_t)r * 512 + h * 64);
#pragma unroll
          for (int j = 0; j < 8; ++j) unpack8(qp[j], q + 8 * j); }
        const float sink = F.in[11][h] * LOG2E;
        const bool prompt = r < NROW_P;
        const int b = r >> 12, i = r & 4095, sr = r - NROW_P, db = sr >> 3, s = sr & 7;
        float sc[3];
#pragma unroll
        for (int rnd = 0; rnd < 3; ++rnd) {
            const int jj = lane + 64 * rnd; bool valid = jj <= WIN; const int jc = valid ? jj : 0; float d = 0.f;
            if (prompt) {
                const int rho = i + jc; valid = valid && (rho >= 112);
                const v4u* kp = (const v4u*)(Kp + (size_t)(b * KVS + rho) * 128 + kvh * 64);
#pragma unroll
                for (int j = 0; j < 8; ++j) { float kf[8]; unpack8(kp[j], kf);
#pragma unroll
                    for (int e = 0; e < 8; ++e) d += q[8 * j + e] * kf[e]; }
            } else {
                const int j2 = s + jc;
                if (j2 < WIN) { const v4f* kp = (const v4f*)(ck + ((size_t)(db * WIN + j2) * 2 + kvh) * 64);
#pragma unroll
                    for (int j = 0; j < 16; ++j) { const v4f kf = kp[j]; d += q[4 * j] * kf.x + q[4 * j + 1] * kf.y + q[4 * j + 2] * kf.z + q[4 * j + 3] * kf.w; } }
                else { const v4u* kp = (const v4u*)(Ks + (size_t)(db * 8 + (j2 - WIN)) * 128 + kvh * 64);
#pragma unroll
                    for (int j = 0; j < 8; ++j) { float kf[8]; unpack8(kp[j], kf);
#pragma unroll
                        for (int e = 0; e < 8; ++e) d += q[8 * j + e] * kf[e]; } }
            }
            sc[rnd] = valid ? d : -INFINITY;
        }
        float m = wave_max(fmaxf(fmaxf(sc[0], sc[1]), sc[2])); m = fmaxf(m, sink);
        float psum = 0.f;
#pragma unroll
        for (int rnd = 0; rnd < 3; ++rnd) { const float p = __builtin_amdgcn_exp2f(sc[rnd] - m); psum += p; pw[lane + 64 * rnd] = p; }
        const float denom = wave_sum(psum) + __builtin_amdgcn_exp2f(sink - m);
        LDS_WAIT(); asm volatile("" ::: "memory");
        float o = 0.f;
        if (prompt) {
            const bf16* vp = Vp + (size_t)(b * KVS + i) * 128 + kvh * 64 + lane;
            for (int jj = 0; jj <= WIN; ++jj) o += pw[jj] * bf2f(vp[(size_t)jj * 128]);
        } else {
            for (int jj = 0; jj <= WIN; ++jj) { const int j2 = s + jj;
                const float v = j2 < WIN ? cv[((size_t)(db * WIN + j2) * 2 + kvh) * 64 + lane] : bf2f(Vs[(size_t)(db * 8 + (j2 - WIN)) * 128 + kvh * 64 + lane]);
                o += pw[jj] * v; }
        }
        o = o / denom;
        MIX[(size_t)r * DM + 512 + h * 64 + lane] = (bf16)f2bf(o);
        const float ss = wave_sum(o * o);
        if (lane == 0) atomicAdd(ssq_att + r, ss);
        LDS_WAIT(); asm volatile("" ::: "memory");
    }
    {
        const int gt = gw * 64 + lane, NT = NGW * 64;
        for (int i2 = gt; i2 < NBATCH * WIN * 128; i2 += NT) { const int b = i2 >> 14, w = (i2 >> 7) & 127, c = i2 & 127;
            F.out[O_KWP + i2] = bf2f(Kp[(size_t)(b * KVS + 4096 + w) * 128 + c]); F.out[O_VWP + i2] = bf2f(Vp[(size_t)(b * KVS + 4096 + w) * 128 + c]); }
        for (int i2 = gt; i2 < DECB * DECS * 128; i2 += NT) { const int db = i2 >> 10, s = (i2 >> 7) & 7, c = i2 & 127;
            F.out[O_KWS + (size_t)db * 16384 + (120 + s) * 128 + c] = bf2f(Ks[i2]); F.out[O_VWS + (size_t)db * 16384 + (120 + s) * 128 + c] = bf2f(Vs[i2]); }
    }
}
__device__ __forceinline__ void p2_simple_ssm(Frame& F) {
    const int gw = F.vcu * NWAVES + F.wave, NGW = F.G * NWAVES, lane = F.lane, p = lane;
    const bf16 *U = WSP(bf16, WS_U), *Us = WSP(bf16, WS_US);
    bf16* MIX = WSP(bf16, WS_MIX); float* ssq_ssm = WSP(float, WS_SSQ);
    for (int it = gw; it < 256 + NG * DECB; it += NGW) {
        const bool prompt = it < 256; const int g = prompt ? (it & 31) : ((it - 256) & 31), bb = prompt ? (it >> 5) : ((it - 256) >> 5);
        const float dt = expf(F.in[14][g]), ar = F.in[12][g * 64 + p], ai = F.in[13][g * 64 + p];
        const float th = ai * dt, mag = expf(ar * dt), cs = cosf(th), sn = sinf(th), lr = mag * cs, li = mag * sn;
        const float sh = sinf(0.5f * th), nr = expm1f(ar * dt) * cs - 2.f * sh * sh, ni = li, den = ar * ar + ai * ai;
        const float fr_ = (nr * ar + ni * ai) / den, fi_ = (ni * ar - nr * ai) / den;
        float bbr[16], bbi[16], cr[16], ci[16], dsk[16], wk[16];
#pragma unroll
        for (int h = 0; h < 16; ++h) { const float br = F.in[15][(size_t)(g * 64 + p) * 16 + h], bi = F.in[16][(size_t)(g * 64 + p) * 16 + h];
            bbr[h] = fr_ * br - fi_ * bi; bbi[h] = fr_ * bi + fi_ * br;
            cr[h] = F.in[17][(size_t)(g * 16 + h) * 64 + p]; ci[h] = F.in[18][(size_t)(g * 16 + h) * 64 + p];
            dsk[h] = F.in[19][g * 16 + h]; wk[h] = F.in[20][(size_t)(g * 16 + h) * 16 + (lane & 15)]; }
        const float bg = F.in[21][g * 16 + (lane & 15)];
        float hr = 0.f, hi = 0.f;
        if (!prompt) { hr = F.in[4][(size_t)(bb * 32 + g) * 64 + p]; hi = F.in[5][(size_t)(bb * 32 + g) * 64 + p]; }
        const int ntok = prompt ? (NMETA + SEQ) : DECS;
        const bf16* ubase = prompt ? U + ((size_t)(g * 8 + bb) * KVS + 112) * 16 : Us + ((size_t)g * 1024 + bb * 8) * 16;
        for (int t = 0; t < ntok; ++t) {
            const v4u* up = (const v4u*)(ubase + (size_t)t * 16);
            float u[16]; unpack8(up[0], u); unpack8(up[1], u + 8);
            float xr = 0.f, xi = 0.f;
#pragma unroll
            for (int h = 0; h < 16; ++h) { xr += bbr[h] * u[h]; xi += bbi[h] * u[h]; }
            const float nhr = lr * hr - li * hi + xr, nhi = lr * hi + li * hr + xi; hr = nhr; hi = nhi;
            float gl[16];
#pragma unroll
            for (int h = 0; h < 16; ++h) { const float y = wave_sum(cr[h] * hr - ci[h] * hi) + dsk[h] * u[h]; gl[h] = gelu_tanh(y); }
            float gate = bg, glk = 0.f;
#pragma unroll
            for (int h = 0; h < 16; ++h) { gate += gl[h] * wk[h]; glk = ((lane & 15) == h) ? gl[h] : glk; }
            const float o = glk * sigmoidf_(gate);
            float ss = o * o; ss += __shfl_xor(ss, 1); ss += __shfl_xor(ss, 2); ss += __shfl_xor(ss, 4); ss += __shfl_xor(ss, 8);
            const int row = prompt ? (t >= NMETA ? bb * SEQ + t - NMETA : -1) : NROW_P + bb * 8 + t;
            if (row >= 0 && lane < 16) { MIX[(size_t)row * DM + g * 16 + lane] = (bf16)f2bf(o); if (lane == 0) atomicAdd(ssq_ssm + row, ss); }
        }
        if (prompt) { F.out[O_SRP + (size_t)(bb * 32 + g) * 64 + p] = hr; F.out[O_SIP + (size_t)(bb * 32 + g) * 64 + p] = hi; }
        else { F.out[O_SRS + (size_t)(bb * 32 + g) * 64 + p] = hr; F.out[O_SIS + (size_t)(bb * 32 + g) * 64 + p] = hi; }
    }
}

typedef short a_bf16x8 __attribute__((ext_vector_type(8)));
typedef float a_f32x16 __attribute__((ext_vector_type(16)));
constexpr int ATT_K_OFF = 0, ATT_V_OFF = 40960, ATT_VS_P = 520, ATT_VS_S = 328;
__device__ __forceinline__ unsigned cvtpk(float lo, float hi) { unsigned r; asm volatile("v_cvt_pk_bf16_f32 %0, %1, %2" : "=v"(r) : "v"(lo), "v"(hi)); return r; }

template <class MaskF>
__device__ __forceinline__ void attn_item(const bf16* qrow, LAS const unsigned char* Kimg, int krow0, LAS const unsigned char* Vt, int vstride, int vkey0, float sink2, MaskF mask,
                                          bf16* orow, float* ssqp, int lane) {
    const int c = lane & 31, hh = lane >> 5;
    a_bf16x8 qf[4];
#pragma unroll
    for (int ks = 0; ks < 4; ++ks) qf[ks] = *(const a_bf16x8*)(qrow + 16 * ks + 8 * hh);
    a_f32x16 st[5];
#pragma unroll
    for (int t = 0; t < 5; ++t) {
        const int row = krow0 + 32 * t + c;
        LAS const unsigned char* kr = Kimg + row * 128;
#pragma unroll
        for (int r = 0; r < 16; ++r) st[t][r] = 0.f;
#pragma unroll
        for (int ks = 0; ks < 4; ++ks) {
            const a_bf16x8 kf = *(LAS const a_bf16x8*)(kr + (((2 * ks + hh) ^ (row & 7)) << 4));
            st[t] = __builtin_amdgcn_mfma_f32_32x32x16_bf16(kf, qf[ks], st[t], 0, 0, 0);
        }
    }
    float mx = sink2;
#pragma unroll
    for (int t = 0; t < 5; ++t)
#pragma unroll
        for (int r = 0; r < 16; ++r) { const int kin = (r & 3) + 8 * (r >> 2) + 4 * hh; const float v = mask(t, kin, c) ? st[t][r] : -INFINITY; st[t][r] = v; mx = fmaxf(mx, v); }
    mx = fmaxf(mx, __shfl_xor(mx, 32));
    float l = 0.f;
#pragma unroll
    for (int t = 0; t < 5; ++t)
#pragma unroll
        for (int r = 0; r < 16; ++r) { const float p = __builtin_amdgcn_exp2f(st[t][r] - mx); st[t][r] = p; l += p; }
    l += __shfl_xor(l, 32);
    l += __builtin_amdgcn_exp2f(sink2 - mx);
    a_f32x16 o[2];
#pragma unroll
    for (int r = 0; r < 16; ++r) { o[0][r] = 0.f; o[1][r] = 0.f; }
#pragma unroll
    for (int t = 0; t < 5; ++t)
#pragma unroll
        for (int s = 0; s < 2; ++s) {
            v4u pw; pw.x = cvtpk(st[t][8 * s + 0], st[t][8 * s + 1]); pw.y = cvtpk(st[t][8 * s + 2], st[t][8 * s + 3]); pw.z = cvtpk(st[t][8 * s + 4], st[t][8 * s + 5]); pw.w = cvtpk(st[t][8 * s + 6], st[t][8 * s + 7]);
            const a_bf16x8 pf = __builtin_bit_cast(a_bf16x8, pw);
#pragma unroll
            for (int dt = 0; dt < 2; ++dt) {
                LAS const unsigned char* vb = Vt + (32 * dt + c) * vstride + (vkey0 + 32 * t + 16 * s + 4 * hh) * 2;
                const v2u lo = *(LAS const v2u*)(vb), hi = *(LAS const v2u*)(vb + 16);
                v4u aw; aw.x = lo.x; aw.y = lo.y; aw.z = hi.x; aw.w = hi.y;
                o[dt] = __builtin_amdgcn_mfma_f32_32x32x16_bf16(__builtin_bit_cast(a_bf16x8, aw), pf, o[dt], 0, 0, 0);
            }
        }
    const float inv = 1.0f / l;
    float ss = 0.f;
#pragma unroll
    for (int dt = 0; dt < 2; ++dt)
#pragma unroll
        for (int rg = 0; rg < 4; ++rg) {
            const float a0 = o[dt][4 * rg] * inv, a1 = o[dt][4 * rg + 1] * inv, a2 = o[dt][4 * rg + 2] * inv, a3 = o[dt][4 * rg + 3] * inv;
            ss += (a0 * a0 + a1 * a1) + (a2 * a2 + a3 * a3);
            v2u w; w.x = cvtpk(a0, a1); w.y = cvtpk(a2, a3);
            *(v2u*)(orow + 32 * dt + 8 * rg + 4 * hh) = w;
        }
    ss += __shfl_xor(ss, 32);
    if (hh == 0) atomicAdd(ssqp, ss);
}

__device__ __forceinline__ void p2_attn(Frame& F) {
    const int lane = F.lane, wave = F.wave, tid = F.tid;
    const bf16 *Q = WSP(bf16, WS_Q), *Kp = WSP(bf16, WS_KP), *Vp = WSP(bf16, WS_VP), *Ks = WSP(bf16, WS_KS), *Vs = WSP(bf16, WS_VS);
    bf16* MIX = WSP(bf16, WS_MIX); float* ssq_att = WSP(float, WS_SSQ) + NROW;
    LAS unsigned char* Kimg = F.lds + RING_OFF + ATT_K_OFF; LAS unsigned char* Vimg = F.lds + RING_OFF + ATT_V_OFF;
    for (int u = F.vcu; u < 512 + DECB; u += F.G) {
        if (u < 512) {
            const int b = u >> 6, qb = (u >> 1) & 31, kvh = u & 1;
            const bf16* kg = Kp + (size_t)(b * KVS + 128 * qb) * 128 + kvh * 64; const bf16* vg = Vp + (size_t)(b * KVS + 128 * qb) * 128 + kvh * 64;
#pragma unroll
            for (int j = 0; j < 4; ++j) { const int pi = tid + 512 * j, row = pi >> 3, ch = pi & 7;
                const v4u kv = *(const v4u*)(kg + (size_t)row * 128 + ch * 8); *(LAS v4u*)(Kimg + row * 128 + ((ch ^ (row & 7)) << 4)) = kv;
                const v4u vv = *(const v4u*)(vg + (size_t)row * 128 + ch * 8);
                LAS unsigned short* vt = (LAS unsigned short*)(Vimg + (8 * ch) * ATT_VS_P + row * 2);
                vt[0 * (ATT_VS_P / 2)] = (unsigned short)(vv.x & 0xffffu); vt[1 * (ATT_VS_P / 2)] = (unsigned short)(vv.x >> 16);
                vt[2 * (ATT_VS_P / 2)] = (unsigned short)(vv.y & 0xffffu); vt[3 * (ATT_VS_P / 2)] = (unsigned short)(vv.y >> 16);
                vt[4 * (ATT_VS_P / 2)] = (unsigned short)(vv.z & 0xffffu); vt[5 * (ATT_VS_P / 2)] = (unsigned short)(vv.z >> 16);
                vt[6 * (ATT_VS_P / 2)] = (unsigned short)(vv.w & 0xffffu); vt[7 * (ATT_VS_P / 2)] = (unsigned short)(vv.w >> 16); }
            __syncthreads();
#pragma unroll 1
            for (int k = 0; k < 2; ++k) {
                const int idx = wave + 8 * k, hq = idx & 3, sb = idx >> 2, h = 4 * kvh + hq;
                const int row = b * SEQ + 128 * qb + 32 * sb + (lane & 31);
                const int rho0 = 128 * qb + 32 * sb;
                auto mask = [=](int t, int kin, int c) { const int kr = 32 * t + kin; return (kr >= c) && (kr <= c + WIN) && (rho0 + kr >= 112); };
                attn_item(Q + (size_t)row * 512 + h * 64, Kimg, 32 * sb, Vimg, ATT_VS_P, 32 * sb, F.in[11][h] * LOG2E, mask, MIX + (size_t)row * DM + 512 + h * 64, ssq_att + row, lane);
            }
            __syncthreads();
        } else {
            const int db = u - 512;
            for (int pi = tid; pi < 2 * 160 * 8; pi += NWAVES * 64) {
                const int ch = pi & 7, rj = pi >> 3, kvh = rj / 160, j = rj % 160;
                v4u kv = (v4u){0u, 0u, 0u, 0u}, vv = (v4u){0u, 0u, 0u, 0u};
                if (j < WIN) { const v4f* kp = (const v4f*)(F.in[2] + ((size_t)(db * WIN + j) * 2 + kvh) * 64 + ch * 8); const v4f* vp = (const v4f*)(F.in[3] + ((size_t)(db * WIN + j) * 2 + kvh) * 64 + ch * 8);
                    const v4f k0 = kp[0], k1 = kp[1], v0 = vp[0], v1 = vp[1];
                    kv.x = pk2(k0.x, k0.y); kv.y = pk2(k0.z, k0.w); kv.z = pk2(k1.x, k1.y); kv.w = pk2(k1.z, k1.w);
                    vv.x = pk2(v0.x, v0.y); vv.y = pk2(v0.z, v0.w); vv.z = pk2(v1.x, v1.y); vv.w = pk2(v1.z, v1.w); }
                else if (j < WIN + DECS) { kv = *(const v4u*)(Ks + (size_t)(db * 8 + j - WIN) * 128 + kvh * 64 + ch * 8); vv = *(const v4u*)(Vs + (size_t)(db * 8 + j - WIN) * 128 + kvh * 64 + ch * 8); }
                *(LAS v4u*)(Kimg + rj * 128 + ((ch ^ (rj & 7)) << 4)) = kv;
                LAS unsigned short* vt = (LAS unsigned short*)(Vimg + (kvh * 64 + 8 * ch) * ATT_VS_S + j * 2);
                vt[0 * (ATT_VS_S / 2)] = (unsigned short)(vv.x & 0xffffu); vt[1 * (ATT_VS_S / 2)] = (unsigned short)(vv.x >> 16);
                vt[2 * (ATT_VS_S / 2)] = (unsigned short)(vv.y & 0xffffu); vt[3 * (ATT_VS_S / 2)] = (unsigned short)(vv.y >> 16);
                vt[4 * (ATT_VS_S / 2)] = (unsigned short)(vv.z & 0xffffu); vt[5 * (ATT_VS_S / 2)] = (unsigned short)(vv.z >> 16);
                vt[6 * (ATT_VS_S / 2)] = (unsigned short)(vv.w & 0xffffu); vt[7 * (ATT_VS_S / 2)] = (unsigned short)(vv.w >> 16);
            }
            __syncthreads();
            if (wave < 2) {
                const int kvh = wave, c = lane & 31, hq = c >> 3, s = c & 7, h = 4 * kvh + hq;
                const int row = NROW_P + db * 8 + s;
                auto mask = [=](int t, int kin, int cc) { const int j = 32 * t + kin, s2 = cc & 7; return (j >= s2) && (j <= s2 + WIN) && (j < WIN + DECS); };
                attn_item(Q + (size_t)row * 512 + h * 64, Kimg, kvh * 160, Vimg + kvh * 64 * ATT_VS_S, ATT_VS_S, 0, F.in[11][h] * LOG2E, mask, MIX + (size_t)row * DM + 512 + h * 64, ssq_att + row, lane);
            }
            __syncthreads();
        }
    }
    {
        const int gw = F.vcu * NWAVES + F.wave, NGW = F.G * NWAVES;
        const int gt = gw * 64 + lane, NT = NGW * 64;
        for (int i2 = gt; i2 < NBATCH * WIN * 128; i2 += NT) { const int b = i2 >> 14, w = (i2 >> 7) & 127, c = i2 & 127;
            F.out[O_KWP + i2] = bf2f(Kp[(size_t)(b * KVS + 4096 + w) * 128 + c]); F.out[O_VWP + i2] = bf2f(Vp[(size_t)(b * KVS + 4096 + w) * 128 + c]); }
        for (int i2 = gt; i2 < DECB * DECS * 128; i2 += NT) { const int db = i2 >> 10, s = (i2 >> 7) & 7, c = i2 & 127;
            F.out[O_KWS + (size_t)db * 16384 + (120 + s) * 128 + c] = bf2f(Ks[i2]); F.out[O_VWS + (size_t)db * 16384 + (120 + s) * 128 + c] = bf2f(Vs[i2]); }
    }
}


struct Args { const float* in[29]; float* out; unsigned char* ws; int ph_lo, ph_hi; };
__global__ void __launch_bounds__(NWAVES * 64, 2) hymba_fwd(Args args) {
    extern __shared__ __attribute__((aligned(16))) unsigned char lds[];
    Frame F;
    F.lds = (LAS unsigned char*)lds;
    F.MISC = (volatile LAS unsigned*)(F.lds + MISC_OFF);
    F.tid = threadIdx.x; F.lane = F.tid & 63; F.wave = __builtin_amdgcn_readfirstlane(F.tid >> 6);
    F.G = gridDim.x; { const int bx = blockIdx.x; F.vcu = (F.G % 8 == 0) ? (bx % 8) * (F.G / 8) + bx / 8 : bx; }
    F.ws = args.ws; F.out = args.out; F.ctl = (gu32*)(args.ws + WS_CTL);
#pragma unroll
    for (int i = 0; i < 29; ++i) F.in[i] = args.in[i];
    for (int u = F.tid; u < (LDS_BYTES - LDSCTL_OFF) / 4; u += NWAVES * 64) ((LAS unsigned*)(F.lds + LDSCTL_OFF))[u] = 0u;
    __syncthreads();
    XcdBarrier bar; bar.bar = (unsigned*)(F.ctl + CW_BAR); bar.x = 0; bar.st = nullptr;
    if (N_LAUNCHES != PER_PHASE) bar = xcd_barrier_post((unsigned*)(F.ctl + CW_BAR), F.MISC + 8);
#define GRID_BAR() do { if (N_LAUNCHES != PER_PHASE) xcd_barrier(bar); } while (0)
    const int lo = args.ph_lo, hi = args.ph_hi;
#define IN(k) (lo <= (k) && (k) < hi)
#define BOTH(k) (IN(k) && IN((k) + 1))

    if (IN(0)) { p0_prologue(F); if (BOTH(0)) GRID_BAR(); }

    if (IN(1)) {
        pg8::Gemm g{WSP(bf16, WS_XN), WSP(bf16, WS_WIN), NROW_IN, INC, DM}; pg8::StaticOrder S; S.init(NROW_IN, INC, F.G, (int)blockIdx.x);
        pg8::EpiInProj E{WSP(bf16, WS_Q), WSP(bf16, WS_KP), WSP(bf16, WS_VP), WSP(bf16, WS_KS), WSP(bf16, WS_VS), WSP(bf16, WS_U), WSP(bf16, WS_US), F.in[9], F.in[10]};
        pg8::gemm_phase<pg8::EpiInProj, pg8::StaticOrder, PG8_ALIGN, PG8_SP2>(F.lds + RING_OFF, g, S, E);
        if (BOTH(1)) GRID_BAR();
    }

    if (IN(2)) { p2_simple_ssm(F); p2_attn(F); if (BOTH(2)) GRID_BAR(); }

    if (IN(3)) {
        pg8::Gemm g{WSP(bf16, WS_MIX), WSP(bf16, WS_WO), NROW, DM, DM}; pg8::StaticOrder S; S.init(NROW, DM, F.G, (int)blockIdx.x);
        pg8::EpiOutProj E{F.in[0], F.in[1], F.out, WSP(bf16, WS_HB), WSP(float, WS_SSQ), WSP(float, WS_SSQ) + NROW, WSP(float, WS_SSQ) + 2 * NROW};
        pg8::gemm_phase<pg8::EpiOutProj, pg8::StaticOrder, PG8_ALIGN, PG8_SP2>(F.lds + RING_OFF, g, S, E);
        if (BOTH(3)) GRID_BAR();
    }

    if (IN(4)) {
        pg8::Gemm g{WSP(bf16, WS_HB), WSP(bf16, WS_WGU), NROW, NGU, DM}; pg8::StaticOrder S; S.init(NROW, NGU, F.G, (int)blockIdx.x);
        pg8::EpiGateUp E{WSP(bf16, WS_HFF), WSP(float, WS_SSQ) + 2 * NROW};
        pg8::gemm_phase<pg8::EpiGateUp, pg8::StaticOrder, PG8_ALIGN, PG8_SP2>(F.lds + RING_OFF, g, S, E);
        if (BOTH(4)) GRID_BAR();
    }

    if (IN(5)) {
        pg8::Gemm g{WSP(bf16, WS_HFF), WSP(bf16, WS_WD), NROW, DM, DFF}; pg8::StaticOrder S; S.init(NROW, DM, F.G, (int)blockIdx.x);
        pg8::EpiDown E{F.out};
        pg8::gemm_phase<pg8::EpiDown, pg8::StaticOrder, PG8_ALIGN, PG8_SP2>(F.lds + RING_OFF, g, S, E);
    }
#undef IN
#undef BOTH
}

extern "C" void kernel_launch(void* const* d_in, const int* in_sizes, int n_in, void* d_out, int out_size, void* d_ws, size_t ws_size, hipStream_t stream) {
    static int grid = 0;
    if (grid == 0) {
        if (n_in != 29 || out_size != (int)O_END || ws_size < WS_END) { fprintf(stderr, "kernel_launch: unexpected shapes: n_in %d out %d ws %zu; nothing launched\n", n_in, out_size, ws_size); grid = -1; return; }
        int dev = 0, cus = 0, per_cu = 0;
        if (hipGetDevice(&dev) != hipSuccess || hipDeviceGetAttribute(&cus, hipDeviceAttributeMultiprocessorCount, dev) != hipSuccess) { grid = -1; return; }
        if (hipFuncSetAttribute((const void*)hymba_fwd, hipFuncAttributeMaxDynamicSharedMemorySize, LDS_BYTES) != hipSuccess) { fprintf(stderr, "kernel_launch: hipFuncSetAttribute failed\n"); grid = -1; return; }
        if (hipOccupancyMaxActiveBlocksPerMultiprocessor(&per_cu, (const void*)hymba_fwd, NWAVES * 64, LDS_BYTES) != hipSuccess || per_cu < 1)
            fprintf(stderr, "kernel_launch: note: occupancy query reports %d workgroups per CU\n", per_cu);
        (void)hipGetLastError();
        grid = cus;
    }
    if (grid < 0) return;
    if (hipMemsetAsync((char*)d_ws + WS_CTL, 0, CTL_ZERO_BYTES, stream) != hipSuccess) { fprintf(stderr, "kernel_launch: hipMemsetAsync failed\n"); return; }
    Args a{};
    for (int i = 0; i < 29; ++i) a.in[i] = (const float*)d_in[i];
    a.out = (float*)d_out; a.ws = (unsigned char*)d_ws;
    if (N_LAUNCHES == 1) {
        a.ph_lo = 0; a.ph_hi = PER_PHASE;
        hipLaunchKernelGGL(hymba_fwd, dim3(grid), dim3(NWAVES * 64), LDS_BYTES, stream, a);
    } else {
        for (int li = 0; li < PER_PHASE; ++li) { a.ph_lo = li; a.ph_hi = li + 1; hipLaunchKernelGGL(hymba_fwd, dim3(grid), dim3(NWAVES * 64), LDS_BYTES, stream, a); }
    }
    const hipError_t le = hipPeekAtLastError();
    if (le != hipSuccess) fprintf(stderr, "kernel_launch: launch failed: %s\n", hipGetErrorName(le));
}
```

```cpp
#include <hip/hip_runtime.h>
#include <cstdio>
#include <cstdint>
#include <cmath>

#ifndef MK_N_LAUNCHES
#define MK_N_LAUNCHES 1
#endif

constexpr int DM = 1024, NBATCH = 8, SEQ = 4096, NMETA = 16, DECB = 128, DECS = 8;
constexpr int NROW_P = NBATCH * SEQ;
constexpr int NROW_S = DECB * DECS;
constexpr int NROW = NROW_P + NROW_S;
constexpr int ROW_META = NROW;
constexpr int NROW_IN = 34048;
constexpr int INC = 1280, DFF = 2816, NGU = 2 * DFF;
constexpr int KVS = 4224;
constexpr int NHQ = 8, NKV = 2, HD = 64, NG = 32, GH = 16, NP = 64, WIN = 128;
constexpr float EPS = 1e-6f;
constexpr float LOG2E = 1.4426950408889634f;
constexpr float QSCALE = 0.125f * LOG2E;

constexpr size_t O_Y = 0;
constexpr size_t O_KWP = (size_t)NROW * DM;
constexpr size_t O_VWP = O_KWP + 131072;
constexpr size_t O_SRP = O_VWP + 131072;
constexpr size_t O_SIP = O_SRP + 16384;
constexpr size_t O_KWS = O_SIP + 16384;
constexpr size_t O_VWS = O_KWS + 2097152;
constexpr size_t O_SRS = O_VWS + 2097152;
constexpr size_t O_SIS = O_SRS + 262144;
constexpr size_t O_END = O_SIS + 262144;

constexpr size_t MiB = 1u << 20;
constexpr size_t WS_CTL = 0, CTL_ZERO_BYTES = 1 * MiB;
constexpr size_t WS_WIN = 2 * MiB;
constexpr size_t WS_WO = 5 * MiB;
constexpr size_t WS_WGU = 7 * MiB;
constexpr size_t WS_WD = 18 * MiB;
constexpr size_t WS_SSMC = 24 * MiB;
constexpr size_t WS_SSQ = 28 * MiB;
constexpr size_t WS_KS = 29 * MiB;
constexpr size_t WS_VS = WS_KS + 512 * 1024;
constexpr size_t WS_US = 30 * MiB;
constexpr size_t WS_MIX = 32 * MiB;
constexpr size_t WS_HB = 98 * MiB;
constexpr size_t WS_HFF = 164 * MiB;
constexpr size_t WS_XN = 164 * MiB;
constexpr size_t WS_Q = 231 * MiB;
constexpr size_t WS_KP = 265 * MiB;
constexpr size_t WS_VP = 274 * MiB;
constexpr size_t WS_U = 283 * MiB;
constexpr size_t WS_END = 346 * MiB;
static_assert(WS_XN + (size_t)NROW_IN * DM * 2 <= WS_Q && WS_Q + (size_t)NROW_IN * 512 * 2 <= WS_KP && WS_KP + (size_t)NBATCH * KVS * 128 * 2 <= WS_VP &&
              WS_VP + (size_t)NBATCH * KVS * 128 * 2 <= WS_U && WS_U + (size_t)NG * NBATCH * KVS * 16 * 2 <= WS_END && WS_HFF + (size_t)NROW * DFF * 2 <= WS_END &&
              WS_MIX + (size_t)NROW * DM * 2 <= WS_HB && WS_HB + (size_t)NROW * DM * 2 <= WS_HFF && WS_WD + (size_t)DM * DFF * 2 <= WS_SSMC, "d_ws map");

constexpr int RING_OFF = 0, RING_BYTES = 131072;
constexpr int LDSCTL_OFF = RING_BYTES, MISC_OFF = LDSCTL_OFF + 320;
constexpr int LDS_BYTES = 147456;
constexpr int NWAVES = 8;

#define GAS __attribute__((address_space(1)))
#define LAS __attribute__((address_space(3)))
typedef unsigned short bf16;
typedef unsigned v4u __attribute__((ext_vector_type(4)));
typedef unsigned v2u __attribute__((ext_vector_type(2)));
typedef float v4f __attribute__((ext_vector_type(4)));
typedef GAS unsigned gu32;
#define RLX_AGENT __ATOMIC_RELAXED, __HIP_MEMORY_SCOPE_AGENT
#define LDS_WAIT() asm volatile("s_waitcnt lgkmcnt(0)" ::: "memory")
#define VM_WAIT() asm volatile("s_waitcnt vmcnt(0)" ::: "memory")
__device__ __forceinline__ unsigned f2bf(float f) { unsigned u = __builtin_bit_cast(unsigned, f); return (u + 0x7fffu + ((u >> 16) & 1u)) >> 16; }
__device__ __forceinline__ unsigned pk2(float lo, float hi) { return f2bf(lo) | (f2bf(hi) << 16); }
__device__ __forceinline__ float bflo(unsigned w) { return __builtin_bit_cast(float, w << 16); }
__device__ __forceinline__ float bfhi(unsigned w) { return __builtin_bit_cast(float, w & 0xffff0000u); }
__device__ __forceinline__ float bf2f(bf16 b) { return __builtin_bit_cast(float, (unsigned)b << 16); }
__device__ __forceinline__ float wave_sum(float v) {
#pragma unroll
    for (int o = 1; o < 64; o <<= 1) v += __shfl_xor(v, o);
    return v;
}
__device__ __forceinline__ float wave_max(float v) {
#pragma unroll
    for (int o = 1; o < 64; o <<= 1) v = fmaxf(v, __shfl_xor(v, o));
    return v;
}
__device__ __forceinline__ float gelu_tanh(float x) {
    const float z = 0.7978845608028654f * (x + 0.044715f * x * x * x);
    return x / (1.0f + __builtin_amdgcn_exp2f(-2.0f * LOG2E * z));
}
__device__ __forceinline__ float sigmoidf_(float x) { return 1.0f / (1.0f + __builtin_amdgcn_exp2f(-LOG2E * x)); }

namespace pg8 {
#define PG8_LAS __attribute__((address_space(3)))
typedef unsigned short bf16_t;
typedef short bf16x8 __attribute__((ext_vector_type(8)));
typedef float f32x4 __attribute__((ext_vector_type(4)));
typedef unsigned u32x4 __attribute__((ext_vector_type(4)));
constexpr int BM = 256, BK = 64, HALF = 128, HTB = HALF * BK * 2  , STAGE_BYTES = 8 * HTB, NXCD = 8, WGM = 8;

__host__ __device__ __forceinline__ int lds_byte(int r, int c) { const int st = (r >> 4) * 2 + (c >> 5), rr = r & 15, cc = c & 31, ob = rr * 64 + cc * 2; return st * 1024 + (ob ^ (((ob >> 9) & 1) << 5)); }
__host__ __device__ __forceinline__ void stage_rc(int b, int& R, int& C) { const int st = b / 1024, sb = b % 1024, swz = sb ^ (((sb >> 9) & 1) << 5); R = (st >> 1) * 16 + swz / 64; C = (st & 1) * 32 + (swz % 64) / 2; }
__host__ __device__ __forceinline__ int perm32(int rho) { const int n = rho >> 4, i = rho & 15; return 8 * (i >> 2) + 4 * n + (i & 3); }

struct Unit { int pm, pn; };
struct Gemm { const bf16_t* A; const bf16_t* Bt; int M, N, K; };

struct StaticOrder {
    int nM, nN, nwg, G, c;
    __host__ __device__ void init(int M, int N, int G_, int c_) { nM = M / BM; nN = N / BM; nwg = nM * nN; G = G_; c = c_; }
    __host__ __device__ bool next(int i, Unit& u) const {
        const long L = (long)i * G + c; if (L >= nwg) return false;
        int wgid = (int)L; { const int q = nwg / NXCD, r = nwg % NXCD, xcd = wgid % NXCD, off = wgid / NXCD; wgid = (xcd < r ? xcd * (q + 1) : r * (q + 1) + (xcd - r) * q) + off; }
        const int nig = WGM * nN, gid = wgid / nig, fm = gid * WGM, gsz = (nM - fm) < WGM ? (nM - fm) : WGM;
        u.pm = fm + ((wgid % nig) % gsz); u.pn = (wgid % nig) / gsz; return true;
    }
    __device__ __forceinline__ void a_ready(const Unit&) const {}
    __device__ __forceinline__ void done(const Unit&) const {}
};

__device__ __forceinline__ unsigned cvt_pk_bf16(float lo, float hi) { unsigned r; asm volatile("v_cvt_pk_bf16_f32 %0, %1, %2" : "=v"(r) : "v"(lo), "v"(hi)); return r; }

typedef unsigned u32x2 __attribute__((ext_vector_type(2)));
constexpr int E_NROW_P = 32768, E_NROW = 33792, E_KVS = 4224;
constexpr float E_EPS = 1e-6f, E_QSCALE = 0.125f * 1.4426950408889634f;

struct EpiInProj {
    static constexpr bool PERM = true, AFTER_DRAIN = false, MIDSCALE = false;
    bf16_t *Q, *Kp, *Vp, *Ks, *Vs, *U, *Us; const float *gq, *gk;
    __device__ __forceinline__ void mid(f32x4 (&)[2][2][4][2], const Unit&, int, int) const {}
    __device__ __forceinline__ void operator()(const f32x4 (&acc)[2][2][4][2], const Unit& u, int wr, int wc, int fr, int fq) const {
        const int pn = u.pn, pm = u.pm;
        if (pn <= 2) {
            const bool isq = pn < 2, isk = (pn == 2) && (wc < 2), normed = isq || isk;
            const float* gp = isq ? gq : gk;
            f32x4 gv[2][2];
#pragma unroll
            for (int bj = 0; bj < 2; ++bj)
#pragma unroll
                for (int n = 0; n < 2; ++n) { f32x4 g = normed ? *(const f32x4*)(gp + 32 * bj + 8 * fq + 4 * n) : (f32x4){1.f, 1.f, 1.f, 1.f}; if (isq) g = g * E_QSCALE; gv[bj][n] = g; }
#pragma unroll
            for (int ai = 0; ai < 2; ++ai)
#pragma unroll
                for (int m = 0; m < 4; ++m) {
                    const int r = pm * BM + ai * HALF + wr * 64 + m * 16 + fr;
                    f32x4 v[2][2]; float ss = 0.f;
#pragma unroll
                    for (int bj = 0; bj < 2; ++bj)
#pragma unroll
                        for (int n = 0; n < 2; ++n) { v[bj][n] = acc[ai][bj][m][n]; const f32x4 x = v[bj][n]; ss += (x[0] * x[0] + x[1] * x[1]) + (x[2] * x[2] + x[3] * x[3]); }
                    float rs = 1.f;
                    if (normed) { ss += __shfl_xor(ss, 16); ss += __shfl_xor(ss, 32); rs = rsqrtf(ss * (1.0f / 64.0f) + E_EPS); }
                    u32x4 w[2];
#pragma unroll
                    for (int bj = 0; bj < 2; ++bj) { const f32x4 a = v[bj][0] * gv[bj][0] * rs, b = v[bj][1] * gv[bj][1] * rs;
                        w[bj].x = cvt_pk_bf16(a[0], a[1]); w[bj].y = cvt_pk_bf16(a[2], a[3]); w[bj].z = cvt_pk_bf16(b[0], b[1]); w[bj].w = cvt_pk_bf16(b[2], b[3]); }
                    if (isq) {
                        bf16_t* d = Q + (size_t)r * 512 + (4 * pn + wc) * 64 + 8 * fq;
                        *(u32x4*)(d) = w[0]; *(u32x4*)(d + 32) = w[1];
                    } else {
                        const int col = (wc & 1) * 64 + 8 * fq;
                        bf16_t* basep = isk ? Kp : Vp; bf16_t* bases = isk ? Ks : Vs;
                        if (pm < 128) { bf16_t* d = basep + (size_t)((pm >> 4) * E_KVS + 128 + (r & 4095)) * 128 + col; *(u32x4*)(d) = w[0]; *(u32x4*)(d + 32) = w[1]; }
                        else if (pm < 132) { bf16_t* d = bases + (size_t)(r - E_NROW_P) * 128 + col; *(u32x4*)(d) = w[0]; *(u32x4*)(d + 32) = w[1]; }
                        else { const int j = r - E_NROW; if (j < 16) {
#pragma unroll
                            for (int b = 0; b < 8; ++b) { bf16_t* d = basep + (size_t)(b * E_KVS + 112 + j) * 128 + col; *(u32x4*)(d) = w[0]; *(u32x4*)(d + 32) = w[1]; } } }
                    }
                }
        } else {
#pragma unroll
            for (int ai = 0; ai < 2; ++ai)
#pragma unroll
                for (int m = 0; m < 4; ++m) {
                    const int r = pm * BM + ai * HALF + wr * 64 + m * 16 + fr;
#pragma unroll
                    for (int bj = 0; bj < 2; ++bj) {
                        const f32x4 a = acc[ai][bj][m][0], b = acc[ai][bj][m][1];
                        u32x4 w; w.x = cvt_pk_bf16(a[0], a[1]); w.y = cvt_pk_bf16(a[2], a[3]); w.z = cvt_pk_bf16(b[0], b[1]); w.w = cvt_pk_bf16(b[2], b[3]);
                        const int g = 16 * (pn - 3) + 8 * bj + 2 * wc + (fq >> 1), ch = 8 * (fq & 1);
                        if (pm < 128) { *(u32x4*)(U + ((size_t)(g * 8 + (pm >> 4)) * E_KVS + 128 + (r & 4095)) * 16 + ch) = w; }
                        else if (pm < 132) { *(u32x4*)(Us + ((size_t)g * 1024 + (r - E_NROW_P)) * 16 + ch) = w; }
                        else { const int j = r - E_NROW; if (j < 16) {
#pragma unroll
                            for (int b2 = 0; b2 < 8; ++b2) *(u32x4*)(U + ((size_t)(g * 8 + b2) * E_KVS + 112 + j) * 16 + ch) = w; } }
                    }
                }
        }
    }
};

struct EpiOutProj {
    static constexpr bool PERM = false, AFTER_DRAIN = false, MIDSCALE = true;
    const float *xp, *xs; float* out; bf16_t* HB; const float *ssq_ssm, *ssq_att; float* ssq_h;
    __device__ __forceinline__ void mid(f32x4 (&acc)[2][2][4][2], const Unit& u, int wr, int fr) const {
        asm volatile("" : "+v"(fr));
#pragma unroll
        for (int ai = 0; ai < 2; ++ai)
#pragma unroll
            for (int m = 0; m < 4; ++m) {
                const int r = u.pm * BM + ai * HALF + wr * 64 + m * 16 + fr;
                const float ratio = sqrtf((ssq_att[r] * (1.0f / 512.0f) + E_EPS) / (ssq_ssm[r] * (1.0f / 512.0f) + E_EPS));
#pragma unroll
                for (int bj = 0; bj < 2; ++bj)
#pragma unroll
                    for (int n = 0; n < 2; ++n) acc[ai][bj][m][n] = acc[ai][bj][m][n] * ratio;
            }
    }
    __device__ __forceinline__ void operator()(const f32x4 (&acc)[2][2][4][2], const Unit& u, int wr, int wc, int fr, int fq) const {
        asm volatile("" : "+v"(fr), "+v"(fq));
        const int col0 = u.pn * BM + wc * 32 + 4 * fq;
#pragma unroll
        for (int ai = 0; ai < 2; ++ai)
#pragma unroll
            for (int m = 0; m < 4; ++m) {
                const int r = u.pm * BM + ai * HALF + wr * 64 + m * 16 + fr;
                const float ra = rsqrtf(ssq_att[r] * (1.0f / 512.0f) + E_EPS);
                const float* xrow = (r < E_NROW_P) ? xp + (size_t)r * 1024 : xs + (size_t)(r - E_NROW_P) * 1024;
                float s = 0.f;
#pragma unroll
                for (int bj = 0; bj < 2; ++bj)
#pragma unroll
                    for (int n = 0; n < 2; ++n) {
                        const int c = col0 + bj * HALF + n * 16;
                        const f32x4 h = *(const f32x4*)(xrow + c) + acc[ai][bj][m][n] * ra;
                        *(f32x4*)(out + (size_t)r * 1024 + c) = h;
                        u32x2 w; w.x = cvt_pk_bf16(h[0], h[1]); w.y = cvt_pk_bf16(h[2], h[3]);
                        *(u32x2*)(HB + (size_t)r * 1024 + c) = w;
                        s += (h[0] * h[0] + h[1] * h[1]) + (h[2] * h[2] + h[3] * h[3]);
                    }
                s += __shfl_xor(s, 16); s += __shfl_xor(s, 32);
                if (fq == 0) atomicAdd(ssq_h + r, s);
            }
    }
};

struct EpiGateUp {
    static constexpr bool PERM = true, AFTER_DRAIN = false, MIDSCALE = false;
    bf16_t* HFF; const float* ssq_h;
    __device__ __forceinline__ void mid(f32x4 (&)[2][2][4][2], const Unit&, int, int) const {}
    __device__ __forceinline__ void operator()(const f32x4 (&acc)[2][2][4][2], const Unit& u, int wr, int wc, int fr, int fq) const {
        const int col0 = u.pn * HALF + wc * 32 + 8 * fq;
#pragma unroll
        for (int ai = 0; ai < 2; ++ai)
#pragma unroll
            for (int m = 0; m < 4; ++m) {
                const int r = u.pm * BM + ai * HALF + wr * 64 + m * 16 + fr;
                const float rs = rsqrtf(ssq_h[r] * (1.0f / 1024.0f) + E_EPS);
                float o[8];
#pragma unroll
                for (int n = 0; n < 2; ++n)
#pragma unroll
                    for (int e = 0; e < 4; ++e) { const float g = acc[ai][0][m][n][e] * rs, up = acc[ai][1][m][n][e] * rs;
                        o[4 * n + e] = g * __builtin_amdgcn_rcpf(1.0f + __builtin_amdgcn_exp2f(-1.4426950408889634f * g)) * up; }
                u32x4 w; w.x = cvt_pk_bf16(o[0], o[1]); w.y = cvt_pk_bf16(o[2], o[3]); w.z = cvt_pk_bf16(o[4], o[5]); w.w = cvt_pk_bf16(o[6], o[7]);
                *(u32x4*)(HFF + (size_t)r * 2816 + col0) = w;
            }
    }
};

struct EpiDown {
    static constexpr bool PERM = false, AFTER_DRAIN = false, MIDSCALE = false;
    float* out;
    __device__ __forceinline__ void mid(f32x4 (&)[2][2][4][2], const Unit&, int, int) const {}
    __device__ __forceinline__ void operator()(const f32x4 (&acc)[2][2][4][2], const Unit& u, int wr, int wc, int fr, int fq) const {
        const int col0 = u.pn * BM + wc * 32 + 4 * fq;
#pragma unroll
        for (int ai = 0; ai < 2; ++ai)
#pragma unroll
            for (int m = 0; m < 4; ++m) {
                float* rowp = out + (size_t)(u.pm * BM + ai * HALF + wr * 64 + m * 16 + fr) * 1024 + col0;
#pragma unroll
                for (int bj = 0; bj < 2; ++bj)
#pragma unroll
                    for (int n = 0; n < 2; ++n) { float* p = rowp + bj * HALF + n * 16; *(f32x4*)p = *(const f32x4*)p + acc[ai][bj][m][n]; }
            }
    }
};

template <class Epi, class Sched, bool ALIGN_EPI = false, bool SP2 = false>
__device__ __forceinline__ void gemm_phase(PG8_LAS unsigned char* lds, const Gemm g, const Sched& S, const Epi& E) {
    const int tid = threadIdx.x, wid = __builtin_amdgcn_readfirstlane(tid >> 6), lane = tid & 63, wr = wid >> 2, wc = wid & 3, fr = lane & 15, fq = lane >> 4;
    const int K = g.K, nt = K / BK;
    unsigned voffA[2], voffB[2];
#pragma unroll
    for (int i = 0; i < 2; ++i) { int R, C; stage_rc(tid * 16 + i * 8192, R, C); const int Rb = Epi::PERM ? ((R & ~31) + perm32(R & 31)) : R;
        voffA[i] = (unsigned)(R * K + C) * 2u; voffB[i] = (unsigned)(Rb * K + C) * 2u; }
    const size_t kstep = (size_t)(BK * 2);
    const size_t hstep = (size_t)HALF * K * 2;
    const size_t tstep = 2 * hstep;
    const unsigned ldsw = (unsigned)wid * 1024u;
    const int aoff = lds_byte(wr * 64 + fr, fq * 8), boff = lds_byte(wc * 32 + fr, fq * 8);
#define PG8_SA(b, h) (((b) * 2 + (h)) * HTB)
#define PG8_SB(b, h) ((4 + (b) * 2 + (h)) * HTB)
#define PG8_STAGE(bufoff, gbase, voff) do { _Pragma("unroll") for (int _i = 0; _i < 2; ++_i) \
        __builtin_amdgcn_global_load_lds((const unsigned*)((const char*)(gbase) + (voff)[_i]), (PG8_LAS unsigned*)(lds + (bufoff) + ldsw + _i * 8192), 16, 0, 0); } while (0)
#define PG8_LDA(dst, b, h) do { _Pragma("unroll") for (int m = 0; m < 4; ++m) _Pragma("unroll") for (int k = 0; k < 2; ++k) dst[m][k] = *(const PG8_LAS bf16x8*)(lds + PG8_SA(b, h) + aoff + m * 2048 + k * 1024); } while (0)
#define PG8_LDB(dst, b, h) do { _Pragma("unroll") for (int n = 0; n < 2; ++n) _Pragma("unroll") for (int k = 0; k < 2; ++k) dst[n][k] = *(const PG8_LAS bf16x8*)(lds + PG8_SB(b, h) + boff + n * 2048 + k * 1024); } while (0)
#define PG8_MMA(ai, bj, At, Bt) do { __builtin_amdgcn_s_setprio(1); _Pragma("unroll") for (int m = 0; m < 4; ++m) _Pragma("unroll") for (int n = 0; n < 2; ++n) _Pragma("unroll") for (int k = 0; k < 2; ++k) \
        acc[ai][bj][m][n] = __builtin_amdgcn_mfma_f32_16x16x32_bf16(Bt[n][k], At[m][k], acc[ai][bj][m][n], 0, 0, 0); __builtin_amdgcn_s_setprio(0); } while (0)
#define PG8_WAIT_V(n) asm volatile("s_waitcnt vmcnt(" #n ")" ::: "memory")
#define PG8_WAIT_L(n) asm volatile("s_waitcnt lgkmcnt(" #n ")" ::: "memory")
#define PG8_BAR __builtin_amdgcn_s_barrier()
#define PG8_SCHED __builtin_amdgcn_sched_barrier(0)
    Unit cur, nxt; int ui = 0;
    if (!S.next(0, cur)) return;
    f32x4 acc[2][2][4][2];
#pragma unroll
    for (int a = 0; a < 2; ++a)
#pragma unroll
        for (int b = 0; b < 2; ++b)
#pragma unroll
            for (int m = 0; m < 4; ++m)
#pragma unroll
                for (int n = 0; n < 2; ++n) acc[a][b][m][n] = (f32x4){0.f, 0.f, 0.f, 0.f};
    bf16x8 At[4][2], B0[2][2], B1[2][2];
    const char* cA = (const char*)g.A + (size_t)cur.pm * tstep; const char* cB = (const char*)g.Bt + (size_t)cur.pn * tstep;
    S.a_ready(cur);
    if constexpr (SP2) {
        PG8_STAGE(PG8_SB(0, 0), cB, voffB); PG8_STAGE(PG8_SB(0, 1), cB + hstep, voffB); PG8_STAGE(PG8_SA(0, 0), cA, voffA); PG8_STAGE(PG8_SA(0, 1), cA + hstep, voffA);
        if (wr == 1) PG8_BAR;
        PG8_WAIT_V(2); PG8_BAR;
        PG8_STAGE(PG8_SB(1, 0), cB + kstep, voffB); PG8_STAGE(PG8_SA(1, 0), cA + kstep, voffA); PG8_STAGE(PG8_SB(1, 1), cB + hstep + kstep, voffB);
        PG8_WAIT_V(6); PG8_BAR;
    } else {
        PG8_STAGE(PG8_SB(0, 0), cB, voffB); PG8_STAGE(PG8_SA(0, 0), cA, voffA); PG8_STAGE(PG8_SB(0, 1), cB + hstep, voffB); PG8_STAGE(PG8_SA(0, 1), cA + hstep, voffA);
        if (wr == 1) PG8_BAR;
        PG8_WAIT_V(4); PG8_BAR;
        PG8_STAGE(PG8_SB(1, 0), cB + kstep, voffB); PG8_STAGE(PG8_SA(1, 0), cA + kstep, voffA); PG8_STAGE(PG8_SB(1, 1), cB + hstep + kstep, voffB);
        PG8_WAIT_V(6); PG8_BAR;
    }
    for (;;) {
        const bool has_next = S.next(ui + 1, nxt);
        const char* nA = has_next ? (const char*)g.A + (size_t)nxt.pm * tstep : cA; const char* nB = has_next ? (const char*)g.Bt + (size_t)nxt.pn * tstep : cB;
        for (int t = 0; t < nt; t += 2) {
            if constexpr (Epi::MIDSCALE) { if (t == (nt >> 1)) E.mid(acc, cur, wr, fr); }
            const bool last = (t == nt - 2);
            const char* a1 = cA + (size_t)(t + 1) * kstep;
            const char* a2 = last ? nA : cA + (size_t)(t + 2) * kstep; const char* b2 = last ? nB : cB + (size_t)(t + 2) * kstep;
            const char* a3 = a2 + kstep; const char* b3 = b2 + kstep;
            if (last && has_next) S.a_ready(nxt);
            if constexpr (SP2) {
            PG8_LDB(B0, 0, 0); PG8_LDB(B1, 0, 1); PG8_SCHED; PG8_LDA(At, 0, 0); PG8_STAGE(PG8_SA(1, 1), a1 + hstep, voffA);
            PG8_WAIT_V(8); PG8_WAIT_L(0); PG8_BAR; PG8_MMA(0, 0, At, B0); PG8_MMA(0, 1, At, B1); PG8_BAR; PG8_SCHED;
            PG8_LDA(At, 0, 1); PG8_STAGE(PG8_SB(0, 0), b2, voffB); PG8_STAGE(PG8_SB(0, 1), b2 + hstep, voffB); PG8_STAGE(PG8_SA(0, 0), a2, voffA);
            PG8_WAIT_V(8); PG8_WAIT_L(0); PG8_BAR; PG8_MMA(1, 0, At, B0); PG8_MMA(1, 1, At, B1); PG8_BAR; PG8_SCHED;
            PG8_LDB(B0, 1, 0); PG8_LDB(B1, 1, 1); PG8_SCHED; PG8_LDA(At, 1, 0); PG8_STAGE(PG8_SA(0, 1), a2 + hstep, voffA);
            PG8_WAIT_V(8); PG8_WAIT_L(0); PG8_BAR; PG8_MMA(0, 0, At, B0); PG8_MMA(0, 1, At, B1); PG8_BAR; PG8_SCHED;
            PG8_LDA(At, 1, 1); PG8_STAGE(PG8_SB(1, 0), b3, voffB); PG8_STAGE(PG8_SB(1, 1), b3 + hstep, voffB); PG8_STAGE(PG8_SA(1, 0), a3, voffA);
            PG8_WAIT_V(8); PG8_WAIT_L(0); PG8_BAR; PG8_MMA(1, 0, At, B0); PG8_MMA(1, 1, At, B1); PG8_BAR; PG8_SCHED;
            } else {
            PG8_LDB(B0, 0, 0); PG8_SCHED; PG8_LDA(At, 0, 0); PG8_STAGE(PG8_SA(1, 1), a1 + hstep, voffA);
            PG8_WAIT_L(8); PG8_BAR; PG8_WAIT_L(0); PG8_MMA(0, 0, At, B0); PG8_BAR; PG8_SCHED;
            PG8_LDB(B1, 0, 1); PG8_STAGE(PG8_SB(0, 0), b2, voffB);
            PG8_BAR; PG8_WAIT_L(0); PG8_MMA(0, 1, At, B1); PG8_BAR;
            PG8_LDA(At, 0, 1); PG8_STAGE(PG8_SA(0, 0), a2, voffA);
            PG8_BAR; PG8_WAIT_L(0); PG8_MMA(1, 0, At, B0); PG8_BAR; PG8_SCHED;
            PG8_STAGE(PG8_SB(0, 1), b2 + hstep, voffB);
            PG8_WAIT_V(6); PG8_BAR; PG8_MMA(1, 1, At, B1); PG8_BAR;
            PG8_LDB(B0, 1, 0); PG8_SCHED; PG8_LDA(At, 1, 0); PG8_STAGE(PG8_SA(0, 1), a2 + hstep, voffA);
            PG8_WAIT_L(8); PG8_BAR; PG8_WAIT_L(0); PG8_MMA(0, 0, At, B0); PG8_BAR; PG8_SCHED;
            PG8_LDB(B1, 1, 1); PG8_STAGE(PG8_SB(1, 0), b3, voffB);
            PG8_BAR; PG8_WAIT_L(0); PG8_MMA(0, 1, At, B1); PG8_BAR;
            PG8_LDA(At, 1, 1); PG8_STAGE(PG8_SA(1, 0), a3, voffA);
            PG8_BAR; PG8_WAIT_L(0); PG8_MMA(1, 0, At, B0); PG8_BAR; PG8_SCHED;
            PG8_STAGE(PG8_SB(1, 1), b3 + hstep, voffB);
            PG8_WAIT_V(6); PG8_BAR; PG8_MMA(1, 1, At, B1); PG8_BAR;
            }
        }
        if constexpr (ALIGN_EPI) { if (wr == 0) PG8_BAR; }
        if constexpr (!Epi::AFTER_DRAIN) { E(acc, cur, wr, wc, fr, fq); S.done(cur); }
        if (!has_next) break;
#pragma unroll
        for (int a = 0; a < 2; ++a)
#pragma unroll
            for (int b = 0; b < 2; ++b)
#pragma unroll
                for (int m = 0; m < 4; ++m)
#pragma unroll
                    for (int n = 0; n < 2; ++n) acc[a][b][m][n] = (f32x4){0.f, 0.f, 0.f, 0.f};
        cur = nxt; cA = nA; cB = nB; ++ui;
        if constexpr (ALIGN_EPI) { if (wr == 1) PG8_BAR; }
    }
    PG8_WAIT_V(0);
    if constexpr (!ALIGN_EPI) { if (wr == 0) PG8_BAR; }
    PG8_BAR;
    if constexpr (Epi::AFTER_DRAIN) { E.fused(acc, cur, wr, wc, fr, fq, lds, wid, lane); S.done(cur); }
#undef PG8_SA
#undef PG8_SB
#undef PG8_STAGE
#undef PG8_LDA
#undef PG8_LDB
#undef PG8_MMA
#undef PG8_WAIT_V
#undef PG8_WAIT_L
#undef PG8_BAR
#undef PG8_SCHED
}
}


#ifndef PG8_SP2
#define PG8_SP2 true
#endif
#ifndef PG8_ALIGN
#define PG8_ALIGN true
#endif
constexpr int N_LAUNCHES = MK_N_LAUNCHES;
constexpr int PER_PHASE = 6;
constexpr int CW_TMO = 0, CW_CODE = 1;
constexpr int CW_BAR = 4096;

#define XB_TMO      128
#define XB_XCNT(j)  (256  + 64 * (j))
#define XB_XSUB(j)  (1280 + 64 * (j))
#define XB_XGEN(j)  (2304 + 64 * (j))
#define XB_TOP      3328
#define XB_TOPGEN   3392
#define XCD_BAR_WORDS 3456
#define XB_SPIN_CAP (1u << 18)

__device__ __forceinline__ unsigned xb_ld(unsigned* p)              { return __hip_atomic_load(p, __ATOMIC_RELAXED, __HIP_MEMORY_SCOPE_AGENT); }
__device__ __forceinline__ unsigned xb_add(unsigned* p, unsigned v) { return __hip_atomic_fetch_add(p, v, __ATOMIC_RELAXED, __HIP_MEMORY_SCOPE_AGENT); }
__device__ __forceinline__ unsigned xb_xcc_id() { return (unsigned)__builtin_amdgcn_s_getreg((3 << 11) | 20) & 0xFu; }
#define XB_SPIN(cond, bar) do { unsigned _sp = 0; while (cond) { __builtin_amdgcn_s_sleep(1); \
    if ((++_sp & 255u) == 0u) { if (xb_ld(&(bar)[XB_TMO])) break; if (_sp > XB_SPIN_CAP) { atomicAdd(&(bar)[XB_TMO], 1u); break; } } } } while (0)

struct XcdBarrier {
    unsigned* bar; unsigned x;
    volatile LAS unsigned* st;
};

__device__ __forceinline__ XcdBarrier xcd_barrier_post(unsigned* bar, volatile LAS unsigned* st) {
    XcdBarrier b; b.bar = bar; b.x = xb_xcc_id(); b.st = st;
    if (threadIdx.x == 0) (void)xb_add(&bar[XB_XCNT(b.x)], 1u);
    return b;
}
__device__ __forceinline__ void xcd_barrier_complete(unsigned* bar, unsigned x, unsigned& nloc, unsigned& nx) {
    const unsigned G = gridDim.x * gridDim.y * gridDim.z;
    unsigned sum, cnt, mine, sp = 0u;
    for (;;) {
        sum = 0u; cnt = 0u; mine = 0u;
#pragma unroll
        for (unsigned j = 0; j < 16; ++j) { const unsigned c = xb_ld(&bar[XB_XCNT(j)]); sum += c; cnt += (c > 0u) ? 1u : 0u; mine = (j == x) ? c : mine; }
        if (sum == G) break;
        __builtin_amdgcn_s_sleep(1);
        if ((++sp & 255u) == 0u) { if (xb_ld(&bar[XB_TMO])) break; if (sp > XB_SPIN_CAP) { atomicAdd(&bar[XB_TMO], 1u); break; } }
    }
    nloc = mine > 0u ? mine : 1u; nx = cnt > 0u ? cnt : 1u;
}

__device__ __forceinline__ void xcd_barrier(const XcdBarrier& b) {
    asm volatile("s_waitcnt vmcnt(0)" ::: "memory");
    __syncthreads();
    if (threadIdx.x == 0) {
        unsigned* bar = b.bar;
        __builtin_amdgcn_s_waitcnt(0);
        unsigned nloc = b.st[0], nx = b.st[1];
        if (nloc == 0u) { xcd_barrier_complete(bar, b.x, nloc, nx); b.st[0] = nloc; b.st[1] = nx; }
        const unsigned old = xb_add(&bar[XB_XSUB(b.x)], 1u);
        const unsigned gen = old / nloc;
        if (old + 1u == (gen + 1u) * nloc) {
            __builtin_amdgcn_fence(__ATOMIC_RELEASE, "agent");
            asm volatile("s_waitcnt vmcnt(0)" ::: "memory");
            const unsigned og = xb_add(&bar[XB_TOP], 1u);
            const unsigned tg = og / nx;
            if (og + 1u == (tg + 1u) * nx) xb_add(&bar[XB_TOPGEN], 1u);
            else XB_SPIN(xb_ld(&bar[XB_TOPGEN]) == tg, bar);
            __builtin_amdgcn_fence(__ATOMIC_ACQUIRE, "agent");
            xb_add(&bar[XB_XGEN(b.x)], 1u);
            asm volatile("s_waitcnt vmcnt(0)" ::: "memory");
        } else {
            XB_SPIN(xb_ld(&bar[XB_XGEN(b.x)]) == gen, bar);
            __builtin_amdgcn_fence(__ATOMIC_ACQUIRE, "agent");
            asm volatile("s_waitcnt vmcnt(0)" ::: "memory");
        }
    }
    __syncthreads();
}


struct Frame {
    LAS unsigned char* lds;
    volatile LAS unsigned* MISC;
    gu32* ctl;
    int tid, lane, wave;
    int vcu, G;
    const float* in[29];
    float* out;
    unsigned char* ws;
};
#define WSP(T, off) ((T*)(F.ws + (off)))

typedef float s_f32x4 __attribute__((ext_vector_type(4)));
typedef short s_bf16x8 __attribute__((ext_vector_type(8)));
constexpr int SSMC_STRIDE = 81920;
constexpr int SC_SF = 0, SC_RF = 32768, SC_MF = 65536, SC_WF = 73728, SC_CONST = 74752, SC_BYTES = 76800;
constexpr int SL_EB = 77824, SL_SCR = 94720, SL_SCR_W = 4352;
static_assert(SL_EB + 33 * 128 * 4 <= SL_SCR && SL_SCR + 8 * SL_SCR_W <= RING_BYTES && 32 * SSMC_STRIDE <= 4 * (int)MiB, "ssm LDS / ws map");

__device__ __forceinline__ void p0_ssm_consts(Frame& F, int g, int part) {
    LAS float* lam = (LAS float*)(F.lds + RING_OFF);
    LAS float* bb = lam + 9 * 64 * 2;
    LAS float* cc = bb + 64 * 16 * 2;
    const int tid = F.tid;
    const float dt = expf(F.in[14][g]);
    for (int i = tid; i < 9 * 64; i += NWAVES * 64) { const int d = i >> 6, p = i & 63; const float ar = F.in[12][g * 64 + p], ai = F.in[13][g * 64 + p];
        const float mag = expf(ar * dt * (float)d), th = ai * dt * (float)d; lam[2 * i] = mag * cosf(th); lam[2 * i + 1] = mag * sinf(th); }
    for (int i = tid; i < 1024; i += NWAVES * 64) { const int p = i >> 4, h = i & 15; const float ar = F.in[12][g * 64 + p], ai = F.in[13][g * 64 + p];
        const float th = ai * dt, mag = expf(ar * dt), cs = cosf(th), sn = sinf(th), li = mag * sn, sh = sinf(0.5f * th);
        const float nr = expm1f(ar * dt) * cs - 2.f * sh * sh, ni = li, den = ar * ar + ai * ai, fr_ = (nr * ar + ni * ai) / den, fi_ = (ni * ar - nr * ai) / den;
        const float br = F.in[15][(size_t)(g * 64 + p) * 16 + h], bi = F.in[16][(size_t)(g * 64 + p) * 16 + h];
        bb[2 * i] = fr_ * br - fi_ * bi; bb[2 * i + 1] = fr_ * bi + fi_ * br; }
    for (int i = tid; i < 1024; i += NWAVES * 64) { const int hh = i >> 6, p = i & 63; cc[2 * i] = F.in[17][(size_t)(g * 16 + hh) * 64 + p]; cc[2 * i + 1] = F.in[18][(size_t)(g * 16 + hh) * 64 + p]; }
    __syncthreads();
    unsigned char* base = F.ws + WS_SSMC + (size_t)g * SSMC_STRIDE;
    bf16* SFp = (bf16*)(base + SC_SF); bf16* RFp = (bf16*)(base + SC_RF); bf16* MFp = (bf16*)(base + SC_MF); bf16* WFp = (bf16*)(base + SC_WF); float* CSp = (float*)(base + SC_CONST);
    for (int idx = tid; idx < 2048; idx += NWAVES * 64) {
        const int e = idx & 7, ln = (idx >> 3) & 63, kk = idx >> 9, rho = ln & 15, grp = ln >> 4;
        {
            const int p = 8 * part + (rho >> 1), ri = rho & 1, j = 2 * kk + (grp >> 1), h = 8 * (grp & 1) + e, d = 7 - j;
            const float lr = lam[(d * 64 + p) * 2], li = lam[(d * 64 + p) * 2 + 1], br = bb[(p * 16 + h) * 2], bi = bb[(p * 16 + h) * 2 + 1];
            SFp[((part * 4 + kk) * 64 + ln) * 8 + e] = (bf16)f2bf(ri ? (lr * bi + li * br) : (lr * br - li * bi)); }
        {
            const int hh = rho, p = 16 * kk + 4 * grp + (e >> 1), ri = e & 1, d = part + 1;
            const float lr = lam[(d * 64 + p) * 2], li = lam[(d * 64 + p) * 2 + 1], cr = cc[(hh * 64 + p) * 2], ci = cc[(hh * 64 + p) * 2 + 1];
            RFp[((part * 4 + kk) * 64 + ln) * 8 + e] = (bf16)f2bf(ri ? -(cr * li + ci * lr) : (cr * lr - ci * li)); }
    }
    {
        const int e = tid & 7, ln = tid >> 3, hh = ln & 15, grp = ln >> 4, jl = grp >> 1, h = 8 * (grp & 1) + e, dd = part - jl;
        float val = 0.f;
        if (dd >= 0) {
            for (int p = 0; p < 64; ++p) { const float lr = lam[(dd * 64 + p) * 2], li = lam[(dd * 64 + p) * 2 + 1], cr = cc[(hh * 64 + p) * 2], ci = cc[(hh * 64 + p) * 2 + 1];
                const float tr = cr * lr - ci * li, ti = cr * li + ci * lr; val += tr * bb[(p * 16 + h) * 2] - ti * bb[(p * 16 + h) * 2 + 1]; }
            if (dd == 0 && hh == h) val += F.in[19][g * 16 + hh];
        }
        MFp[(part * 64 + ln) * 8 + e] = (bf16)f2bf(val);
    }
    if (part == 0) {
        { const int e = tid & 7, ln = tid >> 3, ko = ln & 15, grp = ln >> 4; WFp[ln * 8 + e] = (bf16)f2bf(e < 4 ? F.in[20][(size_t)(g * 16 + 4 * grp + e) * 16 + ko] : 0.f); }
        if (tid < 64) { const int p = tid; const float ar = F.in[12][g * 64 + p], ai = F.in[13][g * 64 + p];
            const float m8 = expf(ar * dt * 8.f), t8 = ai * dt * 8.f, m128 = expf(ar * dt * 128.f), t128 = ai * dt * 128.f;
            CSp[p] = m8 * cosf(t8); CSp[64 + p] = m8 * sinf(t8); CSp[128 + p] = m128 * cosf(t128); CSp[192 + p] = m128 * sinf(t128); }
        if (tid < 16) CSp[256 + tid] = F.in[21][g * 16 + tid];
    }
    __syncthreads();
}

template <int MODE>
__device__ __forceinline__ void ssm_block(LAS unsigned char* L, LAS unsigned char* scr, const bf16* ublk, int lane, float hb0, float hb1, LAS float* eb_out,
                                          const float* st_re, const float* st_im, float* so_re, float* so_im, int g, int db0, bf16* mix, float* ssq, int row0) {
    const int c = lane & 15, grp = lane >> 4;
    LAS const float* cst = (LAS const float*)(L + SC_CONST);
    s_bf16x8 ufr[4];
#pragma unroll
    for (int kk = 0; kk < 4; ++kk) ufr[kk] = *(const s_bf16x8*)(ublk + c * 128 + kk * 32 + grp * 8);
    s_f32x4 ev4[8];
#pragma unroll
    for (int mt = 0; mt < 8; ++mt) { s_f32x4 a = (s_f32x4){0.f, 0.f, 0.f, 0.f};
#pragma unroll
        for (int kk = 0; kk < 4; ++kk) a = __builtin_amdgcn_mfma_f32_16x16x32_bf16(*(LAS const s_bf16x8*)(L + SC_SF + ((mt * 4 + kk) * 64 + lane) * 16), ufr[kk], a, 0, 0, 0);
        ev4[mt] = a; }
    float hin[2][16];
#pragma unroll
    for (int hf = 0; hf < 2; ++hf) {
#pragma unroll
        for (int q = 0; q < 4; ++q) *(LAS s_f32x4*)(scr + c * 272 + (8 * q + 2 * grp) * 8) = ev4[4 * hf + q];
        asm volatile("s_waitcnt lgkmcnt(0)" ::: "memory");
        float ev[16];
#pragma unroll
        for (int k = 0; k < 16; ++k) ev[k] = *(LAS const float*)(scr + k * 272 + 4 * lane);
        const float ar = cst[32 * hf + (lane >> 1)], ai = cst[64 + 32 * hf + (lane >> 1)], coef = (lane & 1) ? ai : -ai;
        asm volatile("s_waitcnt lgkmcnt(0)" ::: "memory");
        if (MODE == 2) {
#pragma unroll
            for (int k = 0; k < 16; ++k) { const size_t si = (size_t)((db0 + k) * 32 + g) * 64 + 32 * hf + (lane >> 1);
                const float own = (lane & 1) ? st_im[si] : st_re[si]; hin[hf][k] = own; const float oth = __shfl_xor(own, 1);
                const float hend = ar * own + coef * oth + ev[k]; if (lane & 1) so_im[si] = hend; else so_re[si] = hend; }
        } else {
            float h = (MODE == 1) ? (hf ? hb1 : hb0) : 0.f;
#pragma unroll
            for (int k = 0; k < 16; ++k) { hin[hf][k] = h; const float oth = __shfl_xor(h, 1); h = ar * h + coef * oth + ev[k]; }
            if (MODE == 0) eb_out[64 * hf + lane] = h;
        }
    }
    if (MODE == 0) return;
#pragma unroll
    for (int hf = 0; hf < 2; ++hf)
#pragma unroll
        for (int k = 0; k < 16; ++k) *(LAS unsigned short*)(scr + k * 272 + (64 * hf + lane) * 2) = (unsigned short)f2bf(hin[hf][k]);
    asm volatile("s_waitcnt lgkmcnt(0)" ::: "memory");
    s_bf16x8 hfr[4];
#pragma unroll
    for (int kk = 0; kk < 4; ++kk) hfr[kk] = *(LAS const s_bf16x8*)(scr + c * 272 + 64 * kk + 16 * grp);
    asm volatile("s_waitcnt lgkmcnt(0)" ::: "memory");
    const s_bf16x8 wf = *(LAS const s_bf16x8*)(L + SC_WF + lane * 16);
    s_f32x4 binit;
#pragma unroll
    for (int r = 0; r < 4; ++r) binit[r] = cst[256 + 4 * grp + r];
#pragma unroll
    for (int s = 0; s < 8; ++s) {
        s_f32x4 y = (s_f32x4){0.f, 0.f, 0.f, 0.f};
#pragma unroll
        for (int kk = 0; kk < 4; ++kk) y = __builtin_amdgcn_mfma_f32_16x16x32_bf16(*(LAS const s_bf16x8*)(L + SC_RF + ((s * 4 + kk) * 64 + lane) * 16), hfr[kk], y, 0, 0, 0);
#pragma unroll
        for (int kk = 0; kk < 4; ++kk) if (2 * kk <= s) y = __builtin_amdgcn_mfma_f32_16x16x32_bf16(*(LAS const s_bf16x8*)(L + SC_MF + ((s - 2 * kk) * 64 + lane) * 16), ufr[kk], y, 0, 0, 0);
        float gl[4];
#pragma unroll
        for (int r = 0; r < 4; ++r) { const float x = y[r], z = 0.7978845608028654f * (x + 0.044715f * x * x * x); gl[r] = x * __builtin_amdgcn_rcpf(1.0f + __builtin_amdgcn_exp2f(-2.0f * LOG2E * z)); }
        v4u gw; gw.x = pk2(gl[0], gl[1]); gw.y = pk2(gl[2], gl[3]); gw.z = 0u; gw.w = 0u;
        const s_f32x4 gate = __builtin_amdgcn_mfma_f32_16x16x32_bf16(wf, __builtin_bit_cast(s_bf16x8, gw), binit, 0, 0, 0);
        float o[4], ss = 0.f;
#pragma unroll
        for (int r = 0; r < 4; ++r) { o[r] = gl[r] * __builtin_amdgcn_rcpf(1.0f + __builtin_amdgcn_exp2f(-LOG2E * gate[r])); ss += o[r] * o[r]; }
        ss += __shfl_xor(ss, 16); ss += __shfl_xor(ss, 32);
        const int row = (MODE == 2) ? (NROW_P + (db0 + c) * 8 + s) : (row0 + 8 * c + s);
        v2u w; w.x = pk2(o[0], o[1]); w.y = pk2(o[2], o[3]);
        *(v2u*)(mix + (size_t)row * DM + g * 16 + 4 * grp) = w;
        if (grp == 0) atomicAdd(ssq + row, ss);
    }
}

__device__ __forceinline__ void p2_ssm(Frame& F) {
    const int lane = F.lane, wave = F.wave, tid = F.tid;
    LAS unsigned char* L = F.lds + RING_OFF;
    LAS unsigned char* scr = L + SL_SCR + wave * SL_SCR_W;
    LAS float* EB = (LAS float*)(L + SL_EB);
    bf16* MIX = WSP(bf16, WS_MIX); float* ssq_ssm = WSP(float, WS_SSQ);
    const bf16 *U = WSP(bf16, WS_U), *Us = WSP(bf16, WS_US);
    for (int u = F.vcu; u < 256; u += F.G) {
        const int g = u & 31, b = u >> 5;
        __syncthreads();
        for (int i = tid; i < SC_BYTES / 16; i += NWAVES * 64) ((LAS v4u*)L)[i] = ((const v4u*)(F.ws + WS_SSMC + (size_t)g * SSMC_STRIDE))[i];
        __syncthreads();
        const bf16* ub = U + (size_t)(g * 8 + b) * KVS * 16;
#pragma unroll 1
        for (int i = wave; i < 33; i += NWAVES)
            ssm_block<0>(L, scr, ub + (size_t)i * 128 * 16, lane, 0.f, 0.f, EB + i * 128, nullptr, nullptr, nullptr, nullptr, g, 0, nullptr, nullptr, 0);
        __syncthreads();
        LAS const float* cst = (LAS const float*)(L + SC_CONST);
        float hbin[4][2];
#pragma unroll
        for (int hf = 0; hf < 2; ++hf) {
            const float ar = cst[128 + 32 * hf + (lane >> 1)], ai = cst[192 + 32 * hf + (lane >> 1)], coef = (lane & 1) ? ai : -ai;
            float h = 0.f;
#pragma unroll
            for (int k = 0; k < 4; ++k) hbin[k][hf] = 0.f;
#pragma unroll 1
            for (int i = 0; i < 33; ++i) {
#pragma unroll
                for (int k = 0; k < 4; ++k) hbin[k][hf] = (i == 1 + wave + 8 * k) ? h : hbin[k][hf];
                const float oth = __shfl_xor(h, 1); h = ar * h + coef * oth + EB[i * 128 + 64 * hf + lane];
            }
            if (wave == 0) F.out[((lane & 1) ? O_SIP : O_SRP) + (size_t)(b * 32 + g) * 64 + 32 * hf + (lane >> 1)] = h;
        }
#pragma unroll
        for (int k = 0; k < 4; ++k) { const int i = 1 + wave + 8 * k;
            ssm_block<1>(L, scr, ub + (size_t)i * 128 * 16, lane, hbin[k][0], hbin[k][1], nullptr, nullptr, nullptr, nullptr, nullptr, g, 0, MIX, ssq_ssm, b * SEQ + 128 * (i - 1)); }
        if (wave == 7) ssm_block<2>(L, scr, Us + ((size_t)g * 1024 + b * 128) * 16, lane, 0.f, 0.f, nullptr, F.in[4], F.in[5], F.out + O_SRS, F.out + O_SIS, g, 16 * b, MIX, ssq_ssm, 0);
    }
    __syncthreads();
}

typedef short a_bf16x8 __attribute__((ext_vector_type(8)));
typedef float a_f32x16 __attribute__((ext_vector_type(16)));
constexpr int ATT_K_OFF = 0, ATT_V_OFF = 40960, ATT_VS_P = 520, ATT_VS_S = 328;
__device__ __forceinline__ unsigned cvtpk(float lo, float hi) { unsigned r; asm volatile("v_cvt_pk_bf16_f32 %0, %1, %2" : "=v"(r) : "v"(lo), "v"(hi)); return r; }

template <class MaskF>
__device__ __forceinline__ void attn_item(const bf16* qrow, LAS const unsigned char* Kimg, int krow0, LAS const unsigned char* Vt, int vstride, int vkey0, float sink2, MaskF mask,
                                          bf16* orow, float* ssqp, int lane) {
    const int c = lane & 31, hh = lane >> 5;
    a_bf16x8 qf[4];
#pragma unroll
    for (int ks = 0; ks < 4; ++ks) qf[ks] = *(const a_bf16x8*)(qrow + 16 * ks + 8 * hh);
    a_f32x16 st[5];
#pragma unroll
    for (int t = 0; t < 5; ++t) {
        const int row = krow0 + 32 * t + c;
        LAS const unsigned char* kr = Kimg + row * 128;
#pragma unroll
        for (int r = 0; r < 16; ++r) st[t][r] = 0.f;
#pragma unroll
        for (int ks = 0; ks < 4; ++ks) {
            const a_bf16x8 kf = *(LAS const a_bf16x8*)(kr + (((2 * ks + hh) ^ (row & 7)) << 4));
            st[t] = __builtin_amdgcn_mfma_f32_32x32x16_bf16(kf, qf[ks], st[t], 0, 0, 0);
        }
    }
    float mx = sink2;
#pragma unroll
    for (int t = 0; t < 5; ++t)
#pragma unroll
        for (int r = 0; r < 16; ++r) { const int kin = (r & 3) + 8 * (r >> 2) + 4 * hh; const float v = mask(t, kin, c) ? st[t][r] : -INFINITY; st[t][r] = v; mx = fmaxf(mx, v); }
    mx = fmaxf(mx, __shfl_xor(mx, 32));
    float l = 0.f;
#pragma unroll
    for (int t = 0; t < 5; ++t)
#pragma unroll
        for (int r = 0; r < 16; ++r) { const float p = __builtin_amdgcn_exp2f(st[t][r] - mx); st[t][r] = p; l += p; }
    l += __shfl_xor(l, 32);
    l += __builtin_amdgcn_exp2f(sink2 - mx);
    a_f32x16 o[2];
#pragma unroll
    for (int r = 0; r < 16; ++r) { o[0][r] = 0.f; o[1][r] = 0.f; }
#pragma unroll
    for (int t = 0; t < 5; ++t)
#pragma unroll
        for (int s = 0; s < 2; ++s) {
            v4u pw; pw.x = cvtpk(st[t][8 * s + 0], st[t][8 * s + 1]); pw.y = cvtpk(st[t][8 * s + 2], st[t][8 * s + 3]); pw.z = cvtpk(st[t][8 * s + 4], st[t][8 * s + 5]); pw.w = cvtpk(st[t][8 * s + 6], st[t][8 * s + 7]);
            const a_bf16x8 pf = __builtin_bit_cast(a_bf16x8, pw);
#pragma unroll
            for (int dt = 0; dt < 2; ++dt) {
                LAS const unsigned char* vb = Vt + (32 * dt + c) * vstride + (vkey0 + 32 * t + 16 * s + 4 * hh) * 2;
                const v2u lo = *(LAS const v2u*)(vb), hi = *(LAS const v2u*)(vb + 16);
                v4u aw; aw.x = lo.x; aw.y = lo.y; aw.z = hi.x; aw.w = hi.y;
                o[dt] = __builtin_amdgcn_mfma_f32_32x32x16_bf16(__builtin_bit_cast(a_bf16x8, aw), pf, o[dt], 0, 0, 0);
            }
        }
    const float inv = 1.0f / l;
    float ss = 0.f;
#pragma unroll
    for (int dt = 0; dt < 2; ++dt)
#pragma unroll
        for (int rg = 0; rg < 4; ++rg) {
            const float a0 = o[dt][4 * rg] * inv, a1 = o[dt][4 * rg + 1] * inv, a2 = o[dt][4 * rg + 2] * inv, a3 = o[dt][4 * rg + 3] * inv;
            ss += (a0 * a0 + a1 * a1) + (a2 * a2 + a3 * a3);
            v2u w; w.x = cvtpk(a0, a1); w.y = cvtpk(a2, a3);
            *(v2u*)(orow + 32 * dt + 8 * rg + 4 * hh) = w;
        }
    ss += __shfl_xor(ss, 32);
    if (hh == 0) atomicAdd(ssqp, ss);
}

__device__ __forceinline__ void p2_attn(Frame& F) {
    const int lane = F.lane, wave = F.wave, tid = F.tid;
    const bf16 *Q = WSP(bf16, WS_Q), *Kp = WSP(bf16, WS_KP), *Vp = WSP(bf16, WS_VP), *Ks = WSP(bf16, WS_KS), *Vs = WSP(bf16, WS_VS);
    bf16* MIX = WSP(bf16, WS_MIX); float* ssq_att = WSP(float, WS_SSQ) + NROW;
    LAS unsigned char* Kimg = F.lds + RING_OFF + ATT_K_OFF; LAS unsigned char* Vimg = F.lds + RING_OFF + ATT_V_OFF;
    for (int u = F.vcu; u < 512 + DECB; u += F.G) {
        if (u < 512) {
            const int b = u >> 6, qb = (u >> 1) & 31, kvh = u & 1;
            const bf16* kg = Kp + (size_t)(b * KVS + 128 * qb) * 128 + kvh * 64; const bf16* vg = Vp + (size_t)(b * KVS + 128 * qb) * 128 + kvh * 64;
#pragma unroll
            for (int j = 0; j < 4; ++j) { const int pi = tid + 512 * j, row = pi >> 3, ch = pi & 7;
                const v4u kv = *(const v4u*)(kg + (size_t)row * 128 + ch * 8); *(LAS v4u*)(Kimg + row * 128 + ((ch ^ (row & 7)) << 4)) = kv;
                const v4u vv = *(const v4u*)(vg + (size_t)row * 128 + ch * 8);
                LAS unsigned short* vt = (LAS unsigned short*)(Vimg + (8 * ch) * ATT_VS_P + row * 2);
                vt[0 * (ATT_VS_P / 2)] = (unsigned short)(vv.x & 0xffffu); vt[1 * (ATT_VS_P / 2)] = (unsigned short)(vv.x >> 16);
                vt[2 * (ATT_VS_P / 2)] = (unsigned short)(vv.y & 0xffffu); vt[3 * (ATT_VS_P / 2)] = (unsigned short)(vv.y >> 16);
                vt[4 * (ATT_VS_P / 2)] = (unsigned short)(vv.z & 0xffffu); vt[5 * (ATT_VS_P / 2)] = (unsigned short)(vv.z >> 16);
                vt[6 * (ATT_VS_P / 2)] = (unsigned short)(vv.w & 0xffffu); vt[7 * (ATT_VS_P / 2)] = (unsigned short)(vv.w >> 16); }
            __syncthreads();
#pragma unroll 1
            for (int k = 0; k < 2; ++k) {
                const int idx = wave + 8 * k, hq = idx & 3, sb = idx >> 2, h = 4 * kvh + hq;
                const int row = b * SEQ + 128 * qb + 32 * sb + (lane & 31);
                const int rho0 = 128 * qb + 32 * sb;
                auto mask = [=](int t, int kin, int c) { const int kr = 32 * t + kin; return (kr >= c) && (kr <= c + WIN) && (rho0 + kr >= 112); };
                attn_item(Q + (size_t)row * 512 + h * 64, Kimg, 32 * sb, Vimg, ATT_VS_P, 32 * sb, F.in[11][h] * LOG2E, mask, MIX + (size_t)row * DM + 512 + h * 64, ssq_att + row, lane);
            }
            __syncthreads();
        } else {
            const int db = u - 512;
            for (int pi = tid; pi < 2 * 160 * 8; pi += NWAVES * 64) {
                const int ch = pi & 7, rj = pi >> 3, kvh = rj / 160, j = rj % 160;
                v4u kv = (v4u){0u, 0u, 0u, 0u}, vv = (v4u){0u, 0u, 0u, 0u};
                if (j < WIN) { const v4f* kp = (const v4f*)(F.in[2] + ((size_t)(db * WIN + j) * 2 + kvh) * 64 + ch * 8); const v4f* vp = (const v4f*)(F.in[3] + ((size_t)(db * WIN + j) * 2 + kvh) * 64 + ch * 8);
                    const v4f k0 = kp[0], k1 = kp[1], v0 = vp[0], v1 = vp[1];
                    kv.x = pk2(k0.x, k0.y); kv.y = pk2(k0.z, k0.w); kv.z = pk2(k1.x, k1.y); kv.w = pk2(k1.z, k1.w);
                    vv.x = pk2(v0.x, v0.y); vv.y = pk2(v0.z, v0.w); vv.z = pk2(v1.x, v1.y); vv.w = pk2(v1.z, v1.w); }
                else if (j < WIN + DECS) { kv = *(const v4u*)(Ks + (size_t)(db * 8 + j - WIN) * 128 + kvh * 64 + ch * 8); vv = *(const v4u*)(Vs + (size_t)(db * 8 + j - WIN) * 128 + kvh * 64 + ch * 8); }
                *(LAS v4u*)(Kimg + rj * 128 + ((ch ^ (rj & 7)) << 4)) = kv;
                LAS unsigned short* vt = (LAS unsigned short*)(Vimg + (kvh * 64 + 8 * ch) * ATT_VS_S + j * 2);
                vt[0 * (ATT_VS_S / 2)] = (unsigned short)(vv.x & 0xffffu); vt[1 * (ATT_VS_S / 2)] = (unsigned short)(vv.x >> 16);
                vt[2 * (ATT_VS_S / 2)] = (unsigned short)(vv.y & 0xffffu); vt[3 * (ATT_VS_S / 2)] = (unsigned short)(vv.y >> 16);
                vt[4 * (ATT_VS_S / 2)] = (unsigned short)(vv.z & 0xffffu); vt[5 * (ATT_VS_S / 2)] = (unsigned short)(vv.z >> 16);
                vt[6 * (ATT_VS_S / 2)] = (unsigned short)(vv.w & 0xffffu); vt[7 * (ATT_VS_S / 2)] = (unsigned short)(vv.w >> 16);
            }
            __syncthreads();
            if (wave < 2) {
                const int kvh = wave, c = lane & 31, hq = c >> 3, s = c & 7, h = 4 * kvh + hq;
                const int row = NROW_P + db * 8 + s;
                auto mask = [=](int t, int kin, int cc) { const int j = 32 * t + kin, s2 = cc & 7; return (j >= s2) && (j <= s2 + WIN) && (j < WIN + DECS); };
                attn_item(Q + (size_t)row * 512 + h * 64, Kimg, kvh * 160, Vimg + kvh * 64 * ATT_VS_S, ATT_VS_S, 0, F.in[11][h] * LOG2E, mask, MIX + (size_t)row * DM + 512 + h * 64, ssq_att + row, lane);
            }
            __syncthreads();
        }
    }
    {
        const int gw = F.vcu * NWAVES + F.wave, NGW = F.G * NWAVES;
        const int gt = gw * 64 + lane, NT = NGW * 64;
        for (int i2 = gt; i2 < NBATCH * WIN * 128; i2 += NT) { const int b = i2 >> 14, w = (i2 >> 7) & 127, c = i2 & 127;
            F.out[O_KWP + i2] = bf2f(Kp[(size_t)(b * KVS + 4096 + w) * 128 + c]); F.out[O_VWP + i2] = bf2f(Vp[(size_t)(b * KVS + 4096 + w) * 128 + c]); }
        for (int i2 = gt; i2 < DECB * DECS * 128; i2 += NT) { const int db = i2 >> 10, s = (i2 >> 7) & 7, c = i2 & 127;
            F.out[O_KWS + (size_t)db * 16384 + (120 + s) * 128 + c] = bf2f(Ks[i2]); F.out[O_VWS + (size_t)db * 16384 + (120 + s) * 128 + c] = bf2f(Vs[i2]); }
    }
}

__device__ __forceinline__ void tr_item(const float* W, int ldw, int src_k0, int src_n0, const float* kscale, bf16* WT, int ldwt, int dst_n0, int dst_k0, LAS float* scr, int lane) {
#pragma unroll 8
    for (int i = 0; i < 32; ++i) { const int kk = 2 * i + (lane >> 5); float v = W[(size_t)(src_k0 + kk) * ldw + src_n0 + (lane & 31)]; if (kscale) v *= kscale[kk]; scr[kk * 33 + (lane & 31)] = v; }
    LDS_WAIT(); asm volatile("" ::: "memory");
    const int c = lane & 7;
#pragma unroll
    for (int j = 0; j < 4; ++j) { const int n = (lane >> 3) + 8 * j; const LAS float* s = scr + (8 * c) * 33 + n;
        v4u o; o.x = pk2(s[0 * 33], s[1 * 33]); o.y = pk2(s[2 * 33], s[3 * 33]); o.z = pk2(s[4 * 33], s[5 * 33]); o.w = pk2(s[6 * 33], s[7 * 33]);
        *(GAS v4u*)(WT + (size_t)(dst_n0 + n) * ldwt + dst_k0 + 8 * c) = o; }
    LDS_WAIT(); asm volatile("" ::: "memory");
}
__device__ __forceinline__ void p0_prologue(Frame& F) {
    for (int it = F.vcu; it < 256; it += F.G) p0_ssm_consts(F, it & 31, it >> 5);
    LAS float* scr = (LAS float*)(F.lds + RING_OFF + F.wave * 16384);
    const int gw = F.vcu * NWAVES + F.wave, NGW = F.G * NWAVES, lane = F.lane;
    constexpr int I_IN = 16 * 40, I_O = 16 * 32, I_GU = 16 * 176, I_D = 44 * 32, NITEMS = I_IN + I_O + I_GU + I_D;
    for (int it = gw; it < NITEMS; it += NGW) {
        int r = it;
        if (r < I_IN) { const int kb = r / 40, nb = r % 40, n0 = 32 * nb; int s0 = n0;
            if (n0 < 768) { const int pn = n0 >> 8, ct = n0 & 255; s0 = 256 * pn + 64 * ((ct & 127) >> 5) + 32 * (ct >> 7); }
            tr_item(F.in[8], INC, 64 * kb, s0, nullptr, WSP(bf16, WS_WIN), DM, n0, 64 * kb, scr, lane); continue; }
        r -= I_IN;
        if (r < I_O) { const int kb = r / 32, nb = r % 32, k0 = 64 * kb;
            const int sk = k0 < 512 ? k0 + 512 : k0 - 512; const float* ks = k0 < 512 ? F.in[23] + k0 : F.in[22] + (k0 - 512);
            tr_item(F.in[24], DM, sk, 32 * nb, ks, WSP(bf16, WS_WO), DM, 32 * nb, k0, scr, lane); continue; }
        r -= I_O;
        if (r < I_GU) { const int kb = r / 176, nb = r % 176, n0 = 32 * nb, pn = n0 >> 8, ct = n0 & 255;
            const float* W = ct < 128 ? F.in[26] : F.in[27];
            tr_item(W, DFF, 64 * kb, 128 * pn + (ct & 127), F.in[25] + 64 * kb, WSP(bf16, WS_WGU), DM, n0, 64 * kb, scr, lane); continue; }
        r -= I_GU;
        { const int kb = r / 32, nb = r % 32; tr_item(F.in[28], DM, 64 * kb, 32 * nb, nullptr, WSP(bf16, WS_WD), DFF, 32 * nb, 64 * kb, scr, lane); }
    }
    {
        const GAS v4f* gp = (const GAS v4f*)F.in[7] + lane;
        v4f g[4];
#pragma unroll
        for (int j = 0; j < 4; ++j) g[j] = gp[64 * j];
        bf16* XN = WSP(bf16, WS_XN);
        for (int r = gw; r < NROW_IN; r += NGW) {
            GAS unsigned long long* o8 = (GAS unsigned long long*)(XN + (size_t)r * DM) + lane;
            if (r >= ROW_META + NMETA) {
#pragma unroll
                for (int j = 0; j < 4; ++j) o8[64 * j] = 0ull;
                continue;
            }
            const float* xrow = r < NROW_P ? F.in[0] + (size_t)r * DM : (r < NROW ? F.in[1] + (size_t)(r - NROW_P) * DM : F.in[6] + (size_t)(r - NROW) * DM);
            const GAS v4f* xr = (const GAS v4f*)xrow + lane;
            v4f v[4]; float s = 0.f;
#pragma unroll
            for (int j = 0; j < 4; ++j) { v[j] = xr[64 * j]; s += (v[j].x * v[j].x + v[j].y * v[j].y) + (v[j].z * v[j].z + v[j].w * v[j].w); }
            const float rstd = rsqrtf(wave_sum(s) * (1.f / DM) + EPS);
#pragma unroll
            for (int j = 0; j < 4; ++j) { const v4f y = v[j] * g[j] * rstd; o8[64 * j] = (unsigned long long)pk2(y.x, y.y) | ((unsigned long long)pk2(y.z, y.w) << 32); }
        }
    }
    {
        const int gt = gw * 64 + lane, NT = NGW * 64;
        GAS v4f* ssq = (GAS v4f*)WSP(float, WS_SSQ);
        for (int i = gt; i < 3 * NROW / 4; i += NT) ssq[i] = (v4f){0.f, 0.f, 0.f, 0.f};
        for (int i = gt; i < 256 * 224; i += NT) { const int gb = i / 224, w = i % 224; *(GAS v4u*)(F.ws + WS_U + (size_t)gb * KVS * 32 + (size_t)w * 16) = (v4u){0u, 0u, 0u, 0u}; }
        for (int i = gt; i < 8 * 1792; i += NT) { const int b = i / 1792, w = i % 1792;
            *(GAS v4u*)(F.ws + WS_KP + (size_t)b * KVS * 256 + (size_t)w * 16) = (v4u){0u, 0u, 0u, 0u}; *(GAS v4u*)(F.ws + WS_VP + (size_t)b * KVS * 256 + (size_t)w * 16) = (v4u){0u, 0u, 0u, 0u}; }
        for (int i = gt; i < DECB * 3840; i += NT) { const int db = i / 3840, w = i % 3840;
            ((GAS v4f*)(F.out + O_KWS + (size_t)db * 16384))[w] = ((const GAS v4f*)(F.in[2] + (size_t)db * 16384 + 1024))[w];
            ((GAS v4f*)(F.out + O_VWS + (size_t)db * 16384))[w] = ((const GAS v4f*)(F.in[3] + (size_t)db * 16384 + 1024))[w]; }
    }
}

__device__ __forceinline__ void unpack8(const v4u w, float* f) { f[0] = bflo(w.x); f[1] = bfhi(w.x); f[2] = bflo(w.y); f[3] = bfhi(w.y); f[4] = bflo(w.z); f[5] = bfhi(w.z); f[6] = bflo(w.w); f[7] = bfhi(w.w); }
__device__ __forceinline__ void p2_simple_attn(Frame& F) {
    LAS float* pw = (LAS float*)(F.lds + RING_OFF) + F.wave * 192;
    const int gw = F.vcu * NWAVES + F.wave, NGW = F.G * NWAVES, lane = F.lane;
    const bf16 *Q = WSP(bf16, WS_Q), *Kp = WSP(bf16, WS_KP), *Vp = WSP(bf16, WS_VP), *Ks = WSP(bf16, WS_KS), *Vs = WSP(bf16, WS_VS);
    bf16* MIX = WSP(bf16, WS_MIX); float* ssq_att = WSP(float, WS_SSQ) + NROW;
    const float *ck = F.in[2], *cv = F.in[3];
    for (int it = gw; it < NROW * NHQ; it += NGW) {
        const int r = it >> 3, h = it & 7, kvh = h >> 2;
        float q[64];
        { const v4u* qp = (const v4u*)(Q + (size_t)r * 512 + h * 64);
#pragma unroll
          for (int j = 0; j < 8; ++j) unpack8(qp[j], q + 8 * j); }
        const float sink = F.in[11][h] * LOG2E;
        const bool prompt = r < NROW_P;
        const int b = r >> 12, i = r & 4095, sr = r - NROW_P, db = sr >> 3, s = sr & 7;
        float sc[3];
#pragma unroll
        for (int rnd = 0; rnd < 3; ++rnd) {
            const int jj = lane + 64 * rnd; bool valid = jj <= WIN; const int jc = valid ? jj : 0; float d = 0.f;
            if (prompt) {
                const int rho = i + jc; valid = valid && (rho >= 112);
                const v4u* kp = (const v4u*)(Kp + (size_t)(b * KVS + rho) * 128 + kvh * 64);
#pragma unroll
                for (int j = 0; j < 8; ++j) { float kf[8]; unpack8(kp[j], kf);
#pragma unroll
                    for (int e = 0; e < 8; ++e) d += q[8 * j + e] * kf[e]; }
            } else {
                const int j2 = s + jc;
                if (j2 < WIN) { const v4f* kp = (const v4f*)(ck + ((size_t)(db * WIN + j2) * 2 + kvh) * 64);
#pragma unroll
                    for (int j = 0; j < 16; ++j) { const v4f kf = kp[j]; d += q[4 * j] * kf.x + q[4 * j + 1] * kf.y + q[4 * j + 2] * kf.z + q[4 * j + 3] * kf.w; } }
                else { const v4u* kp = (const v4u*)(Ks + (size_t)(db * 8 + (j2 - WIN)) * 128 + kvh * 64);
#pragma unroll
                    for (int j = 0; j < 8; ++j) { float kf[8]; unpack8(kp[j], kf);
#pragma unroll
                        for (int e = 0; e < 8; ++e) d += q[8 * j + e] * kf[e]; } }
            }
            sc[rnd] = valid ? d : -INFINITY;
        }
        float m = wave_max(fmaxf(fmaxf(sc[0], sc[1]), sc[2])); m = fmaxf(m, sink);
        float psum = 0.f;
#pragma unroll
        for (int rnd = 0; rnd < 3; ++rnd) { const float p = __builtin_amdgcn_exp2f(sc[rnd] - m); psum += p; pw[lane + 64 * rnd] = p; }
        const float denom = wave_sum(psum) + __builtin_amdgcn_exp2f(sink - m);
        LDS_WAIT(); asm volatile("" ::: "memory");
        float o = 0.f;
        if (prompt) {
            const bf16* vp = Vp + (size_t)(b * KVS + i) * 128 + kvh * 64 + lane;
            for (int jj = 0; jj <= WIN; ++jj) o += pw[jj] * bf2f(vp[(size_t)jj * 128]);
        } else {
            for (int jj = 0; jj <= WIN; ++jj) { const int j2 = s + jj;
                const float v = j2 < WIN ? cv[((size_t)(db * WIN + j2) * 2 + kvh) * 64 + lane] : bf2f(Vs[(size_t)(db * 8 + (j2 - WIN)) * 128 + kvh * 64 + lane]);
                o += pw[jj] * v; }
        }
        o = o / denom;
        MIX[(size_t)r * DM + 512 + h * 64 + lane] = (bf16)f2bf(o);
        const float ss = wave_sum(o * o);
        if (lane == 0) atomicAdd(ssq_att + r, ss);
        LDS_WAIT(); asm volatile("" ::: "memory");
    }
    {
        const int gt = gw * 64 + lane, NT = NGW * 64;
        for (int i2 = gt; i2 < NBATCH * WIN * 128; i2 += NT) { const int b = i2 >> 14, w = (i2 >> 7) & 127, c = i2 & 127;
            F.out[O_KWP + i2] = bf2f(Kp[(size_t)(b * KVS + 4096 + w) * 128 + c]); F.out[O_VWP + i2] = bf2f(Vp[(size_t)(b * KVS + 4096 + w) * 128 + c]); }
        for (int i2 = gt; i2 < DECB * DECS * 128; i2 += NT) { const int db = i2 >> 10, s = (i2 >> 7) & 7, c = i2 & 127;
            F.out[O_KWS + (size_t)db * 16384 + (120 + s) * 128 + c] = bf2f(Ks[i2]); F.out[O_VWS + (size_t)db * 16384 + (120 + s) * 128 + c] = bf2f(Vs[i2]); }
    }
}
__device__ __forceinline__ void p2_simple_ssm(Frame& F) {
    const int gw = F.vcu * NWAVES + F.wave, NGW = F.G * NWAVES, lane = F.lane, p = lane;
    const bf16 *U = WSP(bf16, WS_U), *Us = WSP(bf16, WS_US);
    bf16* MIX = WSP(bf16, WS_MIX); float* ssq_ssm = WSP(float, WS_SSQ);
    for (int it = gw; it < 256 + NG * DECB; it += NGW) {
        const bool prompt = it < 256; const int g = prompt ? (it & 31) : ((it - 256) & 31), bb = prompt ? (it >> 5) : ((it - 256) >> 5);
        const float dt = expf(F.in[14][g]), ar = F.in[12][g * 64 + p], ai = F.in[13][g * 64 + p];
        const float th = ai * dt, mag = expf(ar * dt), cs = cosf(th), sn = sinf(th), lr = mag * cs, li = mag * sn;
        const float sh = sinf(0.5f * th), nr = expm1f(ar * dt) * cs - 2.f * sh * sh, ni = li, den = ar * ar + ai * ai;
        const float fr_ = (nr * ar + ni * ai) / den, fi_ = (ni * ar - nr * ai) / den;
        float bbr[16], bbi[16], cr[16], ci[16], dsk[16], wk[16];
#pragma unroll
        for (int h = 0; h < 16; ++h) { const float br = F.in[15][(size_t)(g * 64 + p) * 16 + h], bi = F.in[16][(size_t)(g * 64 + p) * 16 + h];
            bbr[h] = fr_ * br - fi_ * bi; bbi[h] = fr_ * bi + fi_ * br;
            cr[h] = F.in[17][(size_t)(g * 16 + h) * 64 + p]; ci[h] = F.in[18][(size_t)(g * 16 + h) * 64 + p];
            dsk[h] = F.in[19][g * 16 + h]; wk[h] = F.in[20][(size_t)(g * 16 + h) * 16 + (lane & 15)]; }
        const float bg = F.in[21][g * 16 + (lane & 15)];
        float hr = 0.f, hi = 0.f;
        if (!prompt) { hr = F.in[4][(size_t)(bb * 32 + g) * 64 + p]; hi = F.in[5][(size_t)(bb * 32 + g) * 64 + p]; }
        const int ntok = prompt ? (NMETA + SEQ) : DECS;
        const bf16* ubase = prompt ? U + ((size_t)(g * 8 + bb) * KVS + 112) * 16 : Us + ((size_t)g * 1024 + bb * 8) * 16;
        for (int t = 0; t < ntok; ++t) {
            const v4u* up = (const v4u*)(ubase + (size_t)t * 16);
            float u[16]; unpack8(up[0], u); unpack8(up[1], u + 8);
            float xr = 0.f, xi = 0.f;
#pragma unroll
            for (int h = 0; h < 16; ++h) { xr += bbr[h] * u[h]; xi += bbi[h] * u[h]; }
            const float nhr = lr * hr - li * hi + xr, nhi = lr * hi + li * hr + xi; hr = nhr; hi = nhi;
            float gl[16];
#pragma unroll
            for (int h = 0; h < 16; ++h) { const float y = wave_sum(cr[h] * hr - ci[h] * hi) + dsk[h] * u[h]; gl[h] = gelu_tanh(y); }
            float gate = bg, glk = 0.f;
#pragma unroll
            for (int h = 0; h < 16; ++h) { gate += gl[h] * wk[h]; glk = ((lane & 15) == h) ? gl[h] : glk; }
            const float o = glk * sigmoidf_(gate);
            float ss = o * o; ss += __shfl_xor(ss, 1); ss += __shfl_xor(ss, 2); ss += __shfl_xor(ss, 4); ss += __shfl_xor(ss, 8);
            const int row = prompt ? (t >= NMETA ? bb * SEQ + t - NMETA : -1) : NROW_P + bb * 8 + t;
            if (row >= 0 && lane < 16) { MIX[(size_t)row * DM + g * 16 + lane] = (bf16)f2bf(o); if (lane == 0) atomicAdd(ssq_ssm + row, ss); }
        }
        if (prompt) { F.out[O_SRP + (size_t)(bb * 32 + g) * 64 + p] = hr; F.out[O_SIP + (size_t)(bb * 32 + g) * 64 + p] = hi; }
        else { F.out[O_SRS + (size_t)(bb * 32 + g) * 64 + p] = hr; F.out[O_SIS + (size_t)(bb * 32 + g) * 64 + p] = hi; }
    }
}

struct Args { const float* in[29]; float* out; unsigned char* ws; int ph_lo, ph_hi; };
__global__ void __launch_bounds__(NWAVES * 64, 2) hymba_fwd(Args args) {
    extern __shared__ __attribute__((aligned(16))) unsigned char lds[];
    Frame F;
    F.lds = (LAS unsigned char*)lds;
    F.MISC = (volatile LAS unsigned*)(F.lds + MISC_OFF);
    F.tid = threadIdx.x; F.lane = F.tid & 63; F.wave = __builtin_amdgcn_readfirstlane(F.tid >> 6);
    F.G = gridDim.x; { const int bx = blockIdx.x; F.vcu = (F.G % 8 == 0) ? (bx % 8) * (F.G / 8) + bx / 8 : bx; }
    F.ws = args.ws; F.out = args.out; F.ctl = (gu32*)(args.ws + WS_CTL);
#pragma unroll
    for (int i = 0; i < 29; ++i) F.in[i] = args.in[i];
    for (int u = F.tid; u < (LDS_BYTES - LDSCTL_OFF) / 4; u += NWAVES * 64) ((LAS unsigned*)(F.lds + LDSCTL_OFF))[u] = 0u;
    __syncthreads();
    XcdBarrier bar; bar.bar = (unsigned*)(F.ctl + CW_BAR); bar.x = 0; bar.st = nullptr;
    if (N_LAUNCHES != PER_PHASE) bar = xcd_barrier_post((unsigned*)(F.ctl + CW_BAR), F.MISC + 8);
#define GRID_BAR() do { if (N_LAUNCHES != PER_PHASE) xcd_barrier(bar); } while (0)
    const int lo = args.ph_lo, hi = args.ph_hi;
#define IN(k) (lo <= (k) && (k) < hi)
#define BOTH(k) (IN(k) && IN((k) + 1))

    if (IN(0)) { p0_prologue(F); if (BOTH(0)) GRID_BAR(); }

    if (IN(1)) {
        pg8::Gemm g{WSP(bf16, WS_XN), WSP(bf16, WS_WIN), NROW_IN, INC, DM}; pg8::StaticOrder S; S.init(NROW_IN, INC, F.G, (int)blockIdx.x);
        pg8::EpiInProj E{WSP(bf16, WS_Q), WSP(bf16, WS_KP), WSP(bf16, WS_VP), WSP(bf16, WS_KS), WSP(bf16, WS_VS), WSP(bf16, WS_U), WSP(bf16, WS_US), F.in[9], F.in[10]};
        pg8::gemm_phase<pg8::EpiInProj, pg8::StaticOrder, PG8_ALIGN, PG8_SP2>(F.lds + RING_OFF, g, S, E);
        if (BOTH(1)) GRID_BAR();
    }

    if (IN(2)) { p2_ssm(F); p2_attn(F); if (BOTH(2)) GRID_BAR(); }

    if (IN(3)) {
        pg8::Gemm g{WSP(bf16, WS_MIX), WSP(bf16, WS_WO), NROW, DM, DM}; pg8::StaticOrder S; S.init(NROW, DM, F.G, (int)blockIdx.x);
        pg8::EpiOutProj E{F.in[0], F.in[1], F.out, WSP(bf16, WS_HB), WSP(float, WS_SSQ), WSP(float, WS_SSQ) + NROW, WSP(float, WS_SSQ) + 2 * NROW};
        pg8::gemm_phase<pg8::EpiOutProj, pg8::StaticOrder, PG8_ALIGN, PG8_SP2>(F.lds + RING_OFF, g, S, E);
        if (BOTH(3)) GRID_BAR();
    }

    if (IN(4)) {
        pg8::Gemm g{WSP(bf16, WS_HB), WSP(bf16, WS_WGU), NROW, NGU, DM}; pg8::StaticOrder S; S.init(NROW, NGU, F.G, (int)blockIdx.x);
        pg8::EpiGateUp E{WSP(bf16, WS_HFF), WSP(float, WS_SSQ) + 2 * NROW};
        pg8::gemm_phase<pg8::EpiGateUp, pg8::StaticOrder, PG8_ALIGN, PG8_SP2>(F.lds + RING_OFF, g, S, E);
        if (BOTH(4)) GRID_BAR();
    }

    if (IN(5)) {
        pg8::Gemm g{WSP(bf16, WS_HFF), WSP(bf16, WS_WD), NROW, DM, DFF}; pg8::StaticOrder S; S.init(NROW, DM, F.G, (int)blockIdx.x);
        pg8::EpiDown E{F.out};
        pg8::gemm_phase<pg8::EpiDown, pg8::StaticOrder, PG8_ALIGN, PG8_SP2>(F.lds + RING_OFF, g, S, E);
    }
#undef IN
#undef BOTH
}

extern "C" void kernel_launch(void* const* d_in, const int* in_sizes, int n_in, void* d_out, int out_size, void* d_ws, size_t ws_size, hipStream_t stream) {
    static int grid = 0;
    if (grid == 0) {
        if (n_in != 29 || out_size != (int)O_END || ws_size < WS_END) { fprintf(stderr, "kernel_launch: unexpected shapes: n_in %d out %d ws %zu; nothing launched\n", n_in, out_size, ws_size); grid = -1; return; }
        int dev = 0, cus = 0, per_cu = 0;
        if (hipGetDevice(&dev) != hipSuccess || hipDeviceGetAttribute(&cus, hipDeviceAttributeMultiprocessorCount, dev) != hipSuccess) { grid = -1; return; }
        if (hipFuncSetAttribute((const void*)hymba_fwd, hipFuncAttributeMaxDynamicSharedMemorySize, LDS_BYTES) != hipSuccess) { fprintf(stderr, "kernel_launch: hipFuncSetAttribute failed\n"); grid = -1; return; }
        if (hipOccupancyMaxActiveBlocksPerMultiprocessor(&per_cu, (const void*)hymba_fwd, NWAVES * 64, LDS_BYTES) != hipSuccess || per_cu < 1)
            fprintf(stderr, "kernel_launch: note: occupancy query reports %d workgroups per CU\n", per_cu);
        (void)hipGetLastError();
        grid = cus;
    }
    if (grid < 0) return;
    if (hipMemsetAsync((char*)d_ws + WS_CTL, 0, CTL_ZERO_BYTES, stream) != hipSuccess) { fprintf(stderr, "kernel_launch: hipMemsetAsync failed\n"); return; }
    Args a{};
    for (int i = 0; i < 29; ++i) a.in[i] = (const float*)d_in[i];
    a.out = (float*)d_out; a.ws = (unsigned char*)d_ws;
    if (N_LAUNCHES == 1) {
        a.ph_lo = 0; a.ph_hi = PER_PHASE;
        hipLaunchKernelGGL(hymba_fwd, dim3(grid), dim3(NWAVES * 64), LDS_BYTES, stream, a);
    } else {
        for (int li = 0; li < PER_PHASE; ++li) { a.ph_lo = li; a.ph_hi = li + 1; hipLaunchKernelGGL(hymba_fwd, dim3(grid), dim3(NWAVES * 64), LDS_BYTES, stream, a); }
    }
    const hipError_t le = hipPeekAtLastError();
    if (le != hipSuccess) fprintf(stderr, "kernel_launch: launch failed: %s\n", hipGetErrorName(le));
}
```

```cpp
#include <hip/hip_runtime.h>
#include <cstdio>
#include <cstdint>
#include <cmath>

#ifndef PROBE_DUP
#define PROBE_DUP -1
#endif
#ifndef MK_N_LAUNCHES
#define MK_N_LAUNCHES 1
#endif

constexpr int DM = 1024, NBATCH = 8, SEQ = 4096, NMETA = 16, DECB = 128, DECS = 8;
constexpr int NROW_P = NBATCH * SEQ;
constexpr int NROW_S = DECB * DECS;
constexpr int NROW = NROW_P + NROW_S;
constexpr int ROW_META = NROW;
constexpr int NROW_IN = 34048;
constexpr int INC = 1280, DFF = 2816, NGU = 2 * DFF;
constexpr int KVS = 4224;
constexpr int NHQ = 8, NKV = 2, HD = 64, NG = 32, GH = 16, NP = 64, WIN = 128;
constexpr float EPS = 1e-6f;
constexpr float LOG2E = 1.4426950408889634f;
constexpr float QSCALE = 0.125f * LOG2E;

constexpr size_t O_Y = 0;
constexpr size_t O_KWP = (size_t)NROW * DM;
constexpr size_t O_VWP = O_KWP + 131072;
constexpr size_t O_SRP = O_VWP + 131072;
constexpr size_t O_SIP = O_SRP + 16384;
constexpr size_t O_KWS = O_SIP + 16384;
constexpr size_t O_VWS = O_KWS + 2097152;
constexpr size_t O_SRS = O_VWS + 2097152;
constexpr size_t O_SIS = O_SRS + 262144;
constexpr size_t O_END = O_SIS + 262144;

constexpr size_t MiB = 1u << 20;
constexpr size_t WS_CTL = 0, CTL_ZERO_BYTES = 1 * MiB;
constexpr size_t WS_WIN = 2 * MiB;
constexpr size_t WS_WO = 5 * MiB;
constexpr size_t WS_WGU = 7 * MiB;
constexpr size_t WS_WD = 18 * MiB;
constexpr size_t WS_SSMC = 24 * MiB;
constexpr size_t WS_SSQ = 28 * MiB;
constexpr size_t WS_KS = 29 * MiB;
constexpr size_t WS_VS = WS_KS + 512 * 1024;
constexpr size_t WS_US = 30 * MiB;
constexpr size_t WS_MIX = 32 * MiB;
constexpr size_t WS_HB = 98 * MiB;
constexpr size_t WS_HFF = 164 * MiB;
constexpr size_t WS_XN = 164 * MiB;
constexpr size_t WS_Q = 231 * MiB;
constexpr size_t WS_KP = 265 * MiB;
constexpr size_t WS_VP = 274 * MiB;
constexpr size_t WS_U = 283 * MiB;
constexpr size_t WS_END = 346 * MiB;
constexpr size_t WS_DUMMY = 346 * MiB;
static_assert(WS_XN + (size_t)NROW_IN * DM * 2 <= WS_Q && WS_Q + (size_t)NROW_IN * 512 * 2 <= WS_KP && WS_KP + (size_t)NBATCH * KVS * 128 * 2 <= WS_VP &&
              WS_VP + (size_t)NBATCH * KVS * 128 * 2 <= WS_U && WS_U + (size_t)NG * NBATCH * KVS * 16 * 2 <= WS_END && WS_HFF + (size_t)NROW * DFF * 2 <= WS_END &&
              WS_MIX + (size_t)NROW * DM * 2 <= WS_HB && WS_HB + (size_t)NROW * DM * 2 <= WS_HFF && WS_WD + (size_t)DM * DFF * 2 <= WS_SSMC, "d_ws map");

constexpr int RING_OFF = 0, RING_BYTES = 131072;
constexpr int LDSCTL_OFF = RING_BYTES, MISC_OFF = LDSCTL_OFF + 320;
constexpr int LDS_BYTES = 147456;
constexpr int NWAVES = 8;
constexpr int CW_TMO = 0, CW_CODE = 1, CW_BAR = 4096, CW_CNT3 = 16384, CW_CNT4 = 32768;
#ifndef MK_MERGE345
#define MK_MERGE345 0
#endif

#define GAS __attribute__((address_space(1)))
#define LAS __attribute__((address_space(3)))
typedef unsigned short bf16;
typedef unsigned v4u __attribute__((ext_vector_type(4)));
typedef unsigned v2u __attribute__((ext_vector_type(2)));
typedef float v4f __attribute__((ext_vector_type(4)));
typedef GAS unsigned gu32;
#define RLX_AGENT __ATOMIC_RELAXED, __HIP_MEMORY_SCOPE_AGENT
#define LDS_WAIT() asm volatile("s_waitcnt lgkmcnt(0)" ::: "memory")
#define VM_WAIT() asm volatile("s_waitcnt vmcnt(0)" ::: "memory")
__device__ __forceinline__ unsigned f2bf(float f) { unsigned u = __builtin_bit_cast(unsigned, f); return (u + 0x7fffu + ((u >> 16) & 1u)) >> 16; }
__device__ __forceinline__ unsigned pk2(float lo, float hi) { return f2bf(lo) | (f2bf(hi) << 16); }
__device__ __forceinline__ float bflo(unsigned w) { return __builtin_bit_cast(float, w << 16); }
__device__ __forceinline__ float bfhi(unsigned w) { return __builtin_bit_cast(float, w & 0xffff0000u); }
__device__ __forceinline__ float bf2f(bf16 b) { return __builtin_bit_cast(float, (unsigned)b << 16); }
__device__ __forceinline__ float wave_sum(float v) {
#pragma unroll
    for (int o = 1; o < 64; o <<= 1) v += __shfl_xor(v, o);
    return v;
}
__device__ __forceinline__ float wave_max(float v) {
#pragma unroll
    for (int o = 1; o < 64; o <<= 1) v = fmaxf(v, __shfl_xor(v, o));
    return v;
}
__device__ __forceinline__ float gelu_tanh(float x) {
    const float z = 0.7978845608028654f * (x + 0.044715f * x * x * x);
    return x / (1.0f + __builtin_amdgcn_exp2f(-2.0f * LOG2E * z));
}
__device__ __forceinline__ float sigmoidf_(float x) { return 1.0f / (1.0f + __builtin_amdgcn_exp2f(-LOG2E * x)); }

namespace pg8 {
#define PG8_LAS __attribute__((address_space(3)))
typedef unsigned short bf16_t;
typedef short bf16x8 __attribute__((ext_vector_type(8)));
typedef float f32x4 __attribute__((ext_vector_type(4)));
typedef unsigned u32x4 __attribute__((ext_vector_type(4)));
typedef unsigned u32x2 __attribute__((ext_vector_type(2)));
constexpr int BM = 256, BK = 64, HALF = 128, HTB = HALF * BK * 2, STAGE_BYTES = 8 * HTB, WGM = 8;

__host__ __device__ __forceinline__ int lds_byte(int r, int c) { const int st = (r >> 4) * 2 + (c >> 5), rr = r & 15, cc = c & 31, ob = rr * 64 + cc * 2; return st * 1024 + (ob ^ (((ob >> 9) & 1) << 5)); }
__host__ __device__ __forceinline__ void stage_rc(int b, int& R, int& C) { const int st = b / 1024, sb = b % 1024, swz = sb ^ (((sb >> 9) & 1) << 5); R = (st >> 1) * 16 + swz / 64; C = (st & 1) * 32 + (swz % 64) / 2; }
__host__ __device__ __forceinline__ int perm32(int rho) { const int n = rho >> 4, i = rho & 15; return 8 * (i >> 2) + 4 * n + (i & 3); }
__device__ __forceinline__ unsigned cvt_pk_bf16(float lo, float hi) { unsigned r; asm volatile("v_cvt_pk_bf16_f32 %0, %1, %2" : "=v"(r) : "v"(lo), "v"(hi)); return r; }

struct Unit { int pm, pn, ph; };
struct GDesc { const bf16_t* A; const bf16_t* Bt; int K; };

struct StreamOrder {
    int G, c;
    int ph0, nM0, nN0, ph1, nM1, nN1, ph2, nM2, nN2, s1, s2, s3;
    unsigned char* ws; unsigned* cnt3; unsigned* cnt4; unsigned* tmo; int counted;
    __device__ __forceinline__ void init1(int G_, int c_, int ph, int nM, int nN, unsigned char* ws_, unsigned* ctl) {
        G = G_; c = c_; ph0 = ph; nM0 = nM; nN0 = nN; s1 = nM * nN; ph1 = ph; nM1 = 1; nN1 = 1; s2 = s1; ph2 = ph; nM2 = 1; nN2 = 1; s3 = s1; ws = ws_; cnt3 = ctl + CW_CNT3; cnt4 = ctl + CW_CNT4; tmo = ctl + CW_TMO; counted = 0; }
    __device__ __forceinline__ void init345(int G_, int c_, unsigned char* ws_, unsigned* ctl) {
        G = G_; c = c_; ph0 = 3; nM0 = NROW / BM; nN0 = DM / BM; s1 = nM0 * nN0; ph1 = 4; nM1 = NROW / BM; nN1 = NGU / BM; s2 = s1 + nM1 * nN1; ph2 = 5; nM2 = NROW / BM; nN2 = DM / BM; s3 = s2 + nM2 * nN2;
        ws = ws_; cnt3 = ctl + CW_CNT3; cnt4 = ctl + CW_CNT4; tmo = ctl + CW_TMO; counted = 1; }
    __device__ __forceinline__ bool next(int i, Unit& u) const {
        const int L = i * G + c; if (L >= s3) return false;
        int idx = L, nM = nM0, nN = nN0, ph = ph0;
        if (L >= s2) { idx = L - s2; nM = nM2; nN = nN2; ph = ph2; } else if (L >= s1) { idx = L - s1; nM = nM1; nN = nN1; ph = ph1; }
        const int nig = WGM * nN, gid = idx / nig, fm = gid * WGM, gsz = (nM - fm) < WGM ? (nM - fm) : WGM, w = idx % nig;
        u.pm = fm + w % gsz; u.pn = w / gsz; u.ph = ph; return true;
    }
    __device__ __forceinline__ GDesc desc(int ph) const {
        GDesc g;
        if (ph == 1) { g.A = (const bf16_t*)(ws + WS_XN); g.Bt = (const bf16_t*)(ws + WS_WIN); g.K = DM; }
        else if (ph == 3) { g.A = (const bf16_t*)(ws + WS_MIX); g.Bt = (const bf16_t*)(ws + WS_WO); g.K = DM; }
        else if (ph == 4) { g.A = (const bf16_t*)(ws + WS_HB); g.Bt = (const bf16_t*)(ws + WS_WGU); g.K = DM; }
        else { g.A = (const bf16_t*)(ws + WS_HFF); g.Bt = (const bf16_t*)(ws + WS_WD); g.K = DFF; }
        return g;
    }
    __device__ __forceinline__ void a_ready(const Unit& u) const {
        if (!counted || u.ph < 4) return;
        const unsigned* w = (u.ph == 4 ? cnt3 : cnt4) + 64 * u.pm; const unsigned need = (u.ph == 4) ? 32u : 176u;
        if (threadIdx.x < 64) {
            const unsigned long long t0 = __builtin_amdgcn_s_memrealtime(); unsigned polls = 0;
            while ((unsigned)__builtin_amdgcn_readfirstlane(__hip_atomic_load(w, __ATOMIC_RELAXED, __HIP_MEMORY_SCOPE_AGENT)) < need) {
                if ((++polls & 255u) == 0u && __builtin_amdgcn_readfirstlane(__hip_atomic_load(tmo, __ATOMIC_RELAXED, __HIP_MEMORY_SCOPE_AGENT)) != 0u) break;
                if (__builtin_amdgcn_s_memrealtime() - t0 > 2000000ull) {
                    if (threadIdx.x == 0) __hip_atomic_store(tmo, 1u, __ATOMIC_RELAXED, __HIP_MEMORY_SCOPE_AGENT);
                    break; }
                __builtin_amdgcn_s_sleep(2); }
            __builtin_amdgcn_fence(__ATOMIC_ACQUIRE, "agent");
            asm volatile("s_waitcnt vmcnt(0)" ::: "memory");
        }
        asm volatile("" ::: "memory"); __builtin_amdgcn_s_barrier(); asm volatile("" ::: "memory");
    }
    __device__ __forceinline__ void done(const Unit& u) const {
        if (!counted || (u.ph != 3 && u.ph != 4)) return;
        asm volatile("s_waitcnt vmcnt(0)" ::: "memory");
        __builtin_amdgcn_fence(__ATOMIC_RELEASE, "agent");
        asm volatile("s_waitcnt vmcnt(0)" ::: "memory");
        if ((threadIdx.x & 63) == 0) __hip_atomic_fetch_add((u.ph == 3 ? cnt3 : cnt4) + 64 * u.pm, 1u, __ATOMIC_RELAXED, __HIP_MEMORY_SCOPE_AGENT);
    }
};

struct EpiAll {
    unsigned char* ws; float* out; const float *xp, *xs, *gq, *gk;
    __device__ __forceinline__ void mid(f32x4 (&acc)[2][2][4][2], const Unit& u, int wr, int fr) const {
        if (u.ph != 3) return;
        asm volatile("" : "+v"(fr));
        const float* ssq_ssm = (const float*)(ws + WS_SSQ); const float* ssq_att = ssq_ssm + NROW;
#pragma unroll
        for (int ai = 0; ai < 2; ++ai)
#pragma unroll
            for (int m = 0; m < 4; ++m) {
                const int r = u.pm * BM + ai * HALF + wr * 64 + m * 16 + fr;
                const float ratio = sqrtf((ssq_att[r] * (1.0f / 512.0f) + EPS) / (ssq_ssm[r] * (1.0f / 512.0f) + EPS));
#pragma unroll
                for (int bj = 0; bj < 2; ++bj)
#pragma unroll
                    for (int n = 0; n < 2; ++n) acc[ai][bj][m][n] = acc[ai][bj][m][n] * ratio;
            }
    }
    __device__ __forceinline__ void epi1(const f32x4 (&acc)[2][2][4][2], const Unit& u, int wr, int wc, int fr, int fq) const {
        const int pn = u.pn, pm = u.pm;
        bf16_t* Q = (bf16_t*)(ws + WS_Q); bf16_t* Kp = (bf16_t*)(ws + WS_KP); bf16_t* Vp = (bf16_t*)(ws + WS_VP); bf16_t* Ks = (bf16_t*)(ws + WS_KS); bf16_t* Vs = (bf16_t*)(ws + WS_VS);
        bf16_t* U = (bf16_t*)(ws + WS_U); bf16_t* Us = (bf16_t*)(ws + WS_US);
        if (pn <= 2) {
            const bool isq = pn < 2, isk = (pn == 2) && (wc < 2), normed = isq || isk;
            const float* gp = isq ? gq : gk;
            f32x4 gv[2][2];
#pragma unroll
            for (int bj = 0; bj < 2; ++bj)
#pragma unroll
                for (int n = 0; n < 2; ++n) { f32x4 g = normed ? *(const f32x4*)(gp + 32 * bj + 8 * fq + 4 * n) : (f32x4){1.f, 1.f, 1.f, 1.f}; if (isq) g = g * QSCALE; gv[bj][n] = g; }
#pragma unroll
            for (int ai = 0; ai < 2; ++ai)
#pragma unroll
                for (int m = 0; m < 4; ++m) {
                    const int r = pm * BM + ai * HALF + wr * 64 + m * 16 + fr;
                    f32x4 v[2][2]; float ss = 0.f;
#pragma unroll
                    for (int bj = 0; bj < 2; ++bj)
#pragma unroll
                        for (int n = 0; n < 2; ++n) { v[bj][n] = acc[ai][bj][m][n]; const f32x4 x = v[bj][n]; ss += (x[0] * x[0] + x[1] * x[1]) + (x[2] * x[2] + x[3] * x[3]); }
                    float rs = 1.f;
                    if (normed) { ss += __shfl_xor(ss, 16); ss += __shfl_xor(ss, 32); rs = rsqrtf(ss * (1.0f / 64.0f) + EPS); }
                    u32x4 w[2];
#pragma unroll
                    for (int bj = 0; bj < 2; ++bj) { const f32x4 a = v[bj][0] * gv[bj][0] * rs, b = v[bj][1] * gv[bj][1] * rs;
                        w[bj].x = cvt_pk_bf16(a[0], a[1]); w[bj].y = cvt_pk_bf16(a[2], a[3]); w[bj].z = cvt_pk_bf16(b[0], b[1]); w[bj].w = cvt_pk_bf16(b[2], b[3]); }
                    if (isq) {
                        bf16_t* d = Q + (size_t)r * 512 + (4 * pn + wc) * 64 + 8 * fq;
                        *(u32x4*)(d) = w[0]; *(u32x4*)(d + 32) = w[1];
                    } else {
                        const int col = (wc & 1) * 64 + 8 * fq;
                        bf16_t* basep = isk ? Kp : Vp; bf16_t* bases = isk ? Ks : Vs;
                        if (pm < 128) { bf16_t* d = basep + (size_t)((pm >> 4) * KVS + 128 + (r & 4095)) * 128 + col; *(u32x4*)(d) = w[0]; *(u32x4*)(d + 32) = w[1]; }
                        else if (pm < 132) { bf16_t* d = bases + (size_t)(r - NROW_P) * 128 + col; *(u32x4*)(d) = w[0]; *(u32x4*)(d + 32) = w[1]; }
                        else { const int j = r - NROW; if (j < 16) {
#pragma unroll
                            for (int b = 0; b < 8; ++b) { bf16_t* d = basep + (size_t)(b * KVS + 112 + j) * 128 + col; *(u32x4*)(d) = w[0]; *(u32x4*)(d + 32) = w[1]; } } }
                    }
                }
        } else {
#pragma unroll
            for (int ai = 0; ai < 2; ++ai)
#pragma unroll
                for (int m = 0; m < 4; ++m) {
                    const int r = pm * BM + ai * HALF + wr * 64 + m * 16 + fr;
#pragma unroll
                    for (int bj = 0; bj < 2; ++bj) {
                        const f32x4 a = acc[ai][bj][m][0], b = acc[ai][bj][m][1];
                        u32x4 w; w.x = cvt_pk_bf16(a[0], a[1]); w.y = cvt_pk_bf16(a[2], a[3]); w.z = cvt_pk_bf16(b[0], b[1]); w.w = cvt_pk_bf16(b[2], b[3]);
                        const int g = 16 * (pn - 3) + 8 * bj + 2 * wc + (fq >> 1), ch = 8 * (fq & 1);
                        if (pm < 128) { *(u32x4*)(U + ((size_t)(g * 8 + (pm >> 4)) * KVS + 128 + (r & 4095)) * 16 + ch) = w; }
                        else if (pm < 132) { *(u32x4*)(Us + ((size_t)g * 1024 + (r - NROW_P)) * 16 + ch) = w; }
                        else { const int j = r - NROW; if (j < 16) {
#pragma unroll
                            for (int b2 = 0; b2 < 8; ++b2) *(u32x4*)(U + ((size_t)(g * 8 + b2) * KVS + 112 + j) * 16 + ch) = w; } }
                    }
                }
        }
    }
    __device__ __forceinline__ void epi3(const f32x4 (&acc)[2][2][4][2], const Unit& u, int wr, int wc, int fr, int fq) const {
        asm volatile("" : "+v"(fr), "+v"(fq));
        const float* ssq_att = (const float*)(ws + WS_SSQ) + NROW; float* ssq_h = (float*)(ws + WS_SSQ) + 2 * NROW; bf16_t* HB = (bf16_t*)(ws + WS_HB);
        const int col0 = u.pn * BM + wc * 32 + 8 * fq;
#pragma unroll
        for (int ai = 0; ai < 2; ++ai)
#pragma unroll
            for (int m = 0; m < 4; ++m) {
                const int r = u.pm * BM + ai * HALF + wr * 64 + m * 16 + fr;
                const float ra = rsqrtf(ssq_att[r] * (1.0f / 512.0f) + EPS);
                const float* xrow = (r < NROW_P) ? xp + (size_t)r * DM : xs + (size_t)(r - NROW_P) * DM;
                float s = 0.f;
#pragma unroll
                for (int bj = 0; bj < 2; ++bj) {
                    const int c = col0 + bj * HALF;
                    const f32x4 h0 = *(const f32x4*)(xrow + c) + acc[ai][bj][m][0] * ra, h1 = *(const f32x4*)(xrow + c + 4) + acc[ai][bj][m][1] * ra;
                    u32x4 w; w.x = cvt_pk_bf16(h0[0], h0[1]); w.y = cvt_pk_bf16(h0[2], h0[3]); w.z = cvt_pk_bf16(h1[0], h1[1]); w.w = cvt_pk_bf16(h1[2], h1[3]);
                    *(u32x4*)(HB + (size_t)r * DM + c) = w;
                    s += (h0[0] * h0[0] + h0[1] * h0[1]) + (h0[2] * h0[2] + h0[3] * h0[3]) + (h1[0] * h1[0] + h1[1] * h1[1]) + (h1[2] * h1[2] + h1[3] * h1[3]);
                }
                s += __shfl_xor(s, 16); s += __shfl_xor(s, 32);
                if (fq == 0) atomicAdd(ssq_h + r, s);
            }
    }
    __device__ __forceinline__ void epi4(const f32x4 (&acc)[2][2][4][2], const Unit& u, int wr, int wc, int fr, int fq) const {
        const float* ssq_h = (const float*)(ws + WS_SSQ) + 2 * NROW; bf16_t* HFF = (bf16_t*)(ws + WS_HFF);
        const int col0 = u.pn * HALF + wc * 32 + 8 * fq;
#pragma unroll
        for (int ai = 0; ai < 2; ++ai)
#pragma unroll
            for (int m = 0; m < 4; ++m) {
                const int r = u.pm * BM + ai * HALF + wr * 64 + m * 16 + fr;
                const float rs = rsqrtf(ssq_h[r] * (1.0f / 1024.0f) + EPS);
                float o[8];
#pragma unroll
                for (int n = 0; n < 2; ++n)
#pragma unroll
                    for (int e = 0; e < 4; ++e) { const float g = acc[ai][0][m][n][e] * rs, up = acc[ai][1][m][n][e] * rs;
                        o[4 * n + e] = g * __builtin_amdgcn_rcpf(1.0f + __builtin_amdgcn_exp2f(-LOG2E * g)) * up; }
                u32x4 w; w.x = cvt_pk_bf16(o[0], o[1]); w.y = cvt_pk_bf16(o[2], o[3]); w.z = cvt_pk_bf16(o[4], o[5]); w.w = cvt_pk_bf16(o[6], o[7]);
                *(u32x4*)(HFF + (size_t)r * DFF + col0) = w;
            }
    }
    __device__ __forceinline__ void epi5(const f32x4 (&acc)[2][2][4][2], const Unit& u, int wr, int wc, int fr, int fq) const {
        asm volatile("" : "+v"(fr), "+v"(fq));
        const bf16_t* HB = (const bf16_t*)(ws + WS_HB);
        const int col0 = u.pn * BM + wc * 32 + 8 * fq;
#pragma unroll
        for (int ai = 0; ai < 2; ++ai)
#pragma unroll
            for (int m = 0; m < 4; ++m) {
                const size_t ro = (size_t)(u.pm * BM + ai * HALF + wr * 64 + m * 16 + fr) * DM + col0;
#pragma unroll
                for (int bj = 0; bj < 2; ++bj) {
                    const u32x4 hb = *(const u32x4*)(HB + ro + bj * HALF);
                    f32x4 h0, h1; h0[0] = bflo(hb.x); h0[1] = bfhi(hb.x); h0[2] = bflo(hb.y); h0[3] = bfhi(hb.y); h1[0] = bflo(hb.z); h1[1] = bfhi(hb.z); h1[2] = bflo(hb.w); h1[3] = bfhi(hb.w);
                    *(f32x4*)(out + ro + bj * HALF) = h0 + acc[ai][bj][m][0]; *(f32x4*)(out + ro + bj * HALF + 4) = h1 + acc[ai][bj][m][1];
                }
            }
    }
    __device__ __forceinline__ void operator()(const f32x4 (&acc)[2][2][4][2], const Unit& u, int wr, int wc, int fr, int fq) const {
        if (u.ph == 1) epi1(acc, u, wr, wc, fr, fq); else if (u.ph == 3) epi3(acc, u, wr, wc, fr, fq); else if (u.ph == 4) epi4(acc, u, wr, wc, fr, fq); else epi5(acc, u, wr, wc, fr, fq);
    }
};


template <class Sched, class Epi>
__device__ __forceinline__ void gemm_stream(PG8_LAS unsigned char* lds, const Sched& S, const Epi& E) {
    const int tid = threadIdx.x, wid = __builtin_amdgcn_readfirstlane(tid >> 6), lane = tid & 63, wr = wid >> 2, wc = wid & 3, fr = lane & 15, fq = lane >> 4;
    unsigned RA2[2], RB2[2], C2[2];
#pragma unroll
    for (int i = 0; i < 2; ++i) { int R, C; stage_rc(tid * 16 + i * 8192, R, C); RA2[i] = 2u * (unsigned)R; RB2[i] = 2u * (unsigned)((R & ~31) + perm32(R & 31)); C2[i] = 2u * (unsigned)C; }
    const size_t kstep = (size_t)(BK * 2);
    const unsigned ldsw = (unsigned)wid * 1024u;
    const int aoff = lds_byte(wr * 64 + fr, fq * 8), boff = lds_byte(wc * 32 + fr, fq * 8);
#define PG8_SA(b, h) (((b) * 2 + (h)) * HTB)
#define PG8_SB(b, h) ((4 + (b) * 2 + (h)) * HTB)
#define PG8_STAGE(bufoff, gbase, voff) do { _Pragma("unroll") for (int _i = 0; _i < 2; ++_i) \
        __builtin_amdgcn_global_load_lds((const unsigned*)((const char*)(gbase) + (voff)[_i]), (PG8_LAS unsigned*)(lds + (bufoff) + ldsw + _i * 8192), 16, 0, 0); } while (0)
#define PG8_LDA(dst, b, h) do { _Pragma("unroll") for (int m = 0; m < 4; ++m) _Pragma("unroll") for (int k = 0; k < 2; ++k) dst[m][k] = *(const PG8_LAS bf16x8*)(lds + PG8_SA(b, h) + aoff + m * 2048 + k * 1024); } while (0)
#define PG8_LDB(dst, b, h) do { _Pragma("unroll") for (int n = 0; n < 2; ++n) _Pragma("unroll") for (int k = 0; k < 2; ++k) dst[n][k] = *(const PG8_LAS bf16x8*)(lds + PG8_SB(b, h) + boff + n * 2048 + k * 1024); } while (0)
#define PG8_MMA(ai, bj, At, Bt) do { __builtin_amdgcn_s_setprio(1); _Pragma("unroll") for (int m = 0; m < 4; ++m) _Pragma("unroll") for (int n = 0; n < 2; ++n) _Pragma("unroll") for (int k = 0; k < 2; ++k) \
        acc[ai][bj][m][n] = __builtin_amdgcn_mfma_f32_16x16x32_bf16(Bt[n][k], At[m][k], acc[ai][bj][m][n], 0, 0, 0); __builtin_amdgcn_s_setprio(0); } while (0)
#define PG8_WAIT_V(n) asm volatile("s_waitcnt vmcnt(" #n ")" ::: "memory")
#define PG8_WAIT_L(n) asm volatile("s_waitcnt lgkmcnt(" #n ")" ::: "memory")
#define PG8_BAR __builtin_amdgcn_s_barrier()
#define PG8_SCHED __builtin_amdgcn_sched_barrier(0)
    Unit cur, nxt; int ui = 0;
    if (!S.next(0, cur)) return;
    f32x4 acc[2][2][4][2];
#pragma unroll
    for (int a = 0; a < 2; ++a)
#pragma unroll
        for (int b = 0; b < 2; ++b)
#pragma unroll
            for (int m = 0; m < 4; ++m)
#pragma unroll
                for (int n = 0; n < 2; ++n) acc[a][b][m][n] = (f32x4){0.f, 0.f, 0.f, 0.f};
    bf16x8 At[4][2], B0[2][2], B1[2][2];
    GDesc gc = S.desc(cur.ph);
    int Kc = gc.K; size_t hstep = (size_t)HALF * Kc * 2;
    const char* cA = (const char*)gc.A + (size_t)cur.pm * 2 * hstep; const char* cB = (const char*)gc.Bt + (size_t)cur.pn * 2 * hstep;
    unsigned voffA[2], voffB[2];
#pragma unroll
    for (int i = 0; i < 2; ++i) { voffA[i] = RA2[i] * (unsigned)Kc + C2[i]; voffB[i] = RB2[i] * (unsigned)Kc + C2[i]; }
    S.a_ready(cur);
    PG8_STAGE(PG8_SB(0, 0), cB, voffB); PG8_STAGE(PG8_SB(0, 1), cB + hstep, voffB); PG8_STAGE(PG8_SA(0, 0), cA, voffA); PG8_STAGE(PG8_SA(0, 1), cA + hstep, voffA);
    if (wr == 1) PG8_BAR;
    PG8_WAIT_V(2); PG8_BAR;
    PG8_STAGE(PG8_SB(1, 0), cB + kstep, voffB); PG8_STAGE(PG8_SA(1, 0), cA + kstep, voffA); PG8_STAGE(PG8_SB(1, 1), cB + hstep + kstep, voffB);
    PG8_WAIT_V(6); PG8_BAR;
    for (;;) {
        const bool has_next = S.next(ui + 1, nxt);
        int Kn = Kc; size_t hstep_n = hstep; const char* nA = cA; const char* nB = cB;
        if (has_next) { const GDesc gn = S.desc(nxt.ph); Kn = gn.K; hstep_n = (size_t)HALF * Kn * 2; nA = (const char*)gn.A + (size_t)nxt.pm * 2 * hstep_n; nB = (const char*)gn.Bt + (size_t)nxt.pn * 2 * hstep_n; }
        const int nt = Kc / BK;
        for (int t = 0; t < nt; t += 2) {
            const bool last = (t == nt - 2);
            const char* a1 = cA + (size_t)(t + 1) * kstep;
            const char* a2 = last ? nA : cA + (size_t)(t + 2) * kstep; const char* b2 = last ? nB : cB + (size_t)(t + 2) * kstep;
            const char* a3 = a2 + kstep; const char* b3 = b2 + kstep;
            const size_t hs2 = last ? hstep_n : hstep; const unsigned K2 = (unsigned)(last ? Kn : Kc);
            unsigned vA2[2], vB2[2];
#pragma unroll
            for (int i = 0; i < 2; ++i) { vA2[i] = RA2[i] * K2 + C2[i]; vB2[i] = RB2[i] * K2 + C2[i]; }
            if (last && has_next) S.a_ready(nxt);
            if (t == (nt >> 1)) E.mid(acc, cur, wr, fr);
            PG8_LDB(B0, 0, 0); PG8_LDB(B1, 0, 1); PG8_SCHED; PG8_LDA(At, 0, 0); PG8_STAGE(PG8_SA(1, 1), a1 + hstep, voffA);
            PG8_WAIT_V(8); PG8_WAIT_L(0); PG8_BAR; PG8_MMA(0, 0, At, B0); PG8_MMA(0, 1, At, B1); PG8_BAR; PG8_SCHED;
            PG8_LDA(At, 0, 1); PG8_STAGE(PG8_SB(0, 0), b2, vB2); PG8_STAGE(PG8_SB(0, 1), b2 + hs2, vB2); PG8_STAGE(PG8_SA(0, 0), a2, vA2);
            PG8_WAIT_V(8); PG8_WAIT_L(0); PG8_BAR; PG8_MMA(1, 0, At, B0); PG8_MMA(1, 1, At, B1); PG8_BAR; PG8_SCHED;
            PG8_LDB(B0, 1, 0); PG8_LDB(B1, 1, 1); PG8_SCHED; PG8_LDA(At, 1, 0); PG8_STAGE(PG8_SA(0, 1), a2 + hs2, vA2);
            PG8_WAIT_V(8); PG8_WAIT_L(0); PG8_BAR; PG8_MMA(0, 0, At, B0); PG8_MMA(0, 1, At, B1); PG8_BAR; PG8_SCHED;
            PG8_LDA(At, 1, 1); PG8_STAGE(PG8_SB(1, 0), b3, vB2); PG8_STAGE(PG8_SB(1, 1), b3 + hs2, vB2); PG8_STAGE(PG8_SA(1, 0), a3, vA2);
            PG8_WAIT_V(8); PG8_WAIT_L(0); PG8_BAR; PG8_MMA(1, 0, At, B0); PG8_MMA(1, 1, At, B1); PG8_BAR; PG8_SCHED;
        }
        if (wr == 0) PG8_BAR;
        E(acc, cur, wr, wc, fr, fq); S.done(cur);
        if (!has_next) break;
#pragma unroll
        for (int a = 0; a < 2; ++a)
#pragma unroll
            for (int b = 0; b < 2; ++b)
#pragma unroll
                for (int m = 0; m < 4; ++m)
#pragma unroll
                    for (int n = 0; n < 2; ++n) acc[a][b][m][n] = (f32x4){0.f, 0.f, 0.f, 0.f};
        cur = nxt; cA = nA; cB = nB; Kc = Kn; hstep = hstep_n; ++ui;
#pragma unroll
        for (int i = 0; i < 2; ++i) { voffA[i] = RA2[i] * (unsigned)Kc + C2[i]; voffB[i] = RB2[i] * (unsigned)Kc + C2[i]; }
        if (wr == 1) PG8_BAR;
    }
    PG8_WAIT_V(0);
    PG8_BAR;
#undef PG8_SA
#undef PG8_SB
#undef PG8_STAGE
#undef PG8_LDA
#undef PG8_LDB
#undef PG8_MMA
#undef PG8_WAIT_V
#undef PG8_WAIT_L
#undef PG8_BAR
#undef PG8_SCHED
}
}


#ifndef PG8_SP2
#define PG8_SP2 true
#endif
#ifndef PG8_ALIGN
#define PG8_ALIGN true
#endif
constexpr int N_LAUNCHES = MK_N_LAUNCHES;
constexpr int PER_PHASE = 6;

#define XB_TMO      128
#define XB_XCNT(j)  (256  + 64 * (j))
#define XB_XSUB(j)  (1280 + 64 * (j))
#define XB_XGEN(j)  (2304 + 64 * (j))
#define XB_TOP      3328
#define XB_TOPGEN   3392
#define XCD_BAR_WORDS 3456
#define XB_SPIN_CAP (1u << 18)

__device__ __forceinline__ unsigned xb_ld(unsigned* p)              { return __hip_atomic_load(p, __ATOMIC_RELAXED, __HIP_MEMORY_SCOPE_AGENT); }
__device__ __forceinline__ unsigned xb_add(unsigned* p, unsigned v) { return __hip_atomic_fetch_add(p, v, __ATOMIC_RELAXED, __HIP_MEMORY_SCOPE_AGENT); }
__device__ __forceinline__ unsigned xb_xcc_id() { return (unsigned)__builtin_amdgcn_s_getreg((3 << 11) | 20) & 0xFu; }
#define XB_SPIN(cond, bar) do { unsigned _sp = 0; while (cond) { __builtin_amdgcn_s_sleep(1); \
    if ((++_sp & 255u) == 0u) { if (xb_ld(&(bar)[XB_TMO])) break; if (_sp > XB_SPIN_CAP) { atomicAdd(&(bar)[XB_TMO], 1u); break; } } } } while (0)

struct XcdBarrier {
    unsigned* bar; unsigned x;
    volatile LAS unsigned* st;
};

__device__ __forceinline__ XcdBarrier xcd_barrier_post(unsigned* bar, volatile LAS unsigned* st) {
    XcdBarrier b; b.bar = bar; b.x = xb_xcc_id(); b.st = st;
    if (threadIdx.x == 0) (void)xb_add(&bar[XB_XCNT(b.x)], 1u);
    return b;
}
__device__ __forceinline__ void xcd_barrier_complete(unsigned* bar, unsigned x, unsigned& nloc, unsigned& nx) {
    const unsigned G = gridDim.x * gridDim.y * gridDim.z;
    unsigned sum, cnt, mine, sp = 0u;
    for (;;) {
        sum = 0u; cnt = 0u; mine = 0u;
#pragma unroll
        for (unsigned j = 0; j < 16; ++j) { const unsigned c = xb_ld(&bar[XB_XCNT(j)]); sum += c; cnt += (c > 0u) ? 1u : 0u; mine = (j == x) ? c : mine; }
        if (sum == G) break;
        __builtin_amdgcn_s_sleep(1);
        if ((++sp & 255u) == 0u) { if (xb_ld(&bar[XB_TMO])) break; if (sp > XB_SPIN_CAP) { atomicAdd(&bar[XB_TMO], 1u); break; } }
    }
    nloc = mine > 0u ? mine : 1u; nx = cnt > 0u ? cnt : 1u;
}

__device__ __forceinline__ void xcd_barrier(const XcdBarrier& b) {
    asm volatile("s_waitcnt vmcnt(0)" ::: "memory");
    __syncthreads();
    if (threadIdx.x == 0) {
        unsigned* bar = b.bar;
        __builtin_amdgcn_s_waitcnt(0);
        unsigned nloc = b.st[0], nx = b.st[1];
        if (nloc == 0u) { xcd_barrier_complete(bar, b.x, nloc, nx); b.st[0] = nloc; b.st[1] = nx; }
        const unsigned old = xb_add(&bar[XB_XSUB(b.x)], 1u);
        const unsigned gen = old / nloc;
        if (old + 1u == (gen + 1u) * nloc) {
            __builtin_amdgcn_fence(__ATOMIC_RELEASE, "agent");
            asm volatile("s_waitcnt vmcnt(0)" ::: "memory");
            const unsigned og = xb_add(&bar[XB_TOP], 1u);
            const unsigned tg = og / nx;
            if (og + 1u == (tg + 1u) * nx) xb_add(&bar[XB_TOPGEN], 1u);
            else XB_SPIN(xb_ld(&bar[XB_TOPGEN]) == tg, bar);
            __builtin_amdgcn_fence(__ATOMIC_ACQUIRE, "agent");
            xb_add(&bar[XB_XGEN(b.x)], 1u);
            asm volatile("s_waitcnt vmcnt(0)" ::: "memory");
        } else {
            XB_SPIN(xb_ld(&bar[XB_XGEN(b.x)]) == gen, bar);
            __builtin_amdgcn_fence(__ATOMIC_ACQUIRE, "agent");
            asm volatile("s_waitcnt vmcnt(0)" ::: "memory");
        }
    }
    __syncthreads();
}


struct Frame {
    LAS unsigned char* lds;
    volatile LAS unsigned* MISC;
    gu32* ctl;
    int tid, lane, wave;
    int vcu, G;
    const float* in[29];
    float* out;
    unsigned char* ws;
    size_t mix_off, ssq_off;
};
#define WSP(T, off) ((T*)(F.ws + (off)))

typedef float s_f32x4 __attribute__((ext_vector_type(4)));
typedef short s_bf16x8 __attribute__((ext_vector_type(8)));
constexpr int SSMC_STRIDE = 81920;
constexpr int SC_SF = 0, SC_RF = 32768, SC_MF = 65536, SC_WF = 73728, SC_CONST = 74752, SC_BYTES = 76800;
constexpr int SL_EB = 77824, SL_SCR = 94720, SL_SCR_W = 4352;
static_assert(SL_EB + 33 * 128 * 4 <= SL_SCR && SL_SCR + 8 * SL_SCR_W <= RING_BYTES && 32 * SSMC_STRIDE <= 4 * (int)MiB, "ssm LDS / ws map");

__device__ __forceinline__ void p0_ssm_consts(Frame& F, int g, int part) {
    LAS float* lam = (LAS float*)(F.lds + RING_OFF);
    LAS float* bb = lam + 9 * 64 * 2;
    LAS float* cc = bb + 64 * 16 * 2;
    const int tid = F.tid;
    const float dt = expf(F.in[14][g]);
    for (int i = tid; i < 9 * 64; i += NWAVES * 64) { const int d = i >> 6, p = i & 63; const float ar = F.in[12][g * 64 + p], ai = F.in[13][g * 64 + p];
        const float mag = expf(ar * dt * (float)d), th = ai * dt * (float)d; lam[2 * i] = mag * cosf(th); lam[2 * i + 1] = mag * sinf(th); }
    for (int i = tid; i < 1024; i += NWAVES * 64) { const int p = i >> 4, h = i & 15; const float ar = F.in[12][g * 64 + p], ai = F.in[13][g * 64 + p];
        const float th = ai * dt, mag = expf(ar * dt), cs = cosf(th), sn = sinf(th), li = mag * sn, sh = sinf(0.5f * th);
        const float nr = expm1f(ar * dt) * cs - 2.f * sh * sh, ni = li, den = ar * ar + ai * ai, fr_ = (nr * ar + ni * ai) / den, fi_ = (ni * ar - nr * ai) / den;
        const float br = F.in[15][(size_t)(g * 64 + p) * 16 + h], bi = F.in[16][(size_t)(g * 64 + p) * 16 + h];
        bb[2 * i] = fr_ * br - fi_ * bi; bb[2 * i + 1] = fr_ * bi + fi_ * br; }
    for (int i = tid; i < 1024; i += NWAVES * 64) { const int hh = i >> 6, p = i & 63; cc[2 * i] = F.in[17][(size_t)(g * 16 + hh) * 64 + p]; cc[2 * i + 1] = F.in[18][(size_t)(g * 16 + hh) * 64 + p]; }
    __syncthreads();
    unsigned char* base = F.ws + WS_SSMC + (size_t)g * SSMC_STRIDE;
    bf16* SFp = (bf16*)(base + SC_SF); bf16* RFp = (bf16*)(base + SC_RF); bf16* MFp = (bf16*)(base + SC_MF); bf16* WFp = (bf16*)(base + SC_WF); float* CSp = (float*)(base + SC_CONST);
    for (int idx = tid; idx < 2048; idx += NWAVES * 64) {
        const int e = idx & 7, ln = (idx >> 3) & 63, kk = idx >> 9, rho = ln & 15, grp = ln >> 4;
        {
            const int p = 8 * part + (rho >> 1), ri = rho & 1, j = 2 * kk + (grp >> 1), h = 8 * (grp & 1) + e, d = 7 - j;
            const float lr = lam[(d * 64 + p) * 2], li = lam[(d * 64 + p) * 2 + 1], br = bb[(p * 16 + h) * 2], bi = bb[(p * 16 + h) * 2 + 1];
            SFp[((part * 4 + kk) * 64 + ln) * 8 + e] = (bf16)f2bf(ri ? (lr * bi + li * br) : (lr * br - li * bi)); }
        {
            const int hh = rho, p = 16 * kk + 4 * grp + (e >> 1), ri = e & 1, d = part + 1;
            const float lr = lam[(d * 64 + p) * 2], li = lam[(d * 64 + p) * 2 + 1], cr = cc[(hh * 64 + p) * 2], ci = cc[(hh * 64 + p) * 2 + 1];
            RFp[((part * 4 + kk) * 64 + ln) * 8 + e] = (bf16)f2bf(ri ? -(cr * li + ci * lr) : (cr * lr - ci * li)); }
    }
    {
        const int e = tid & 7, ln = tid >> 3, hh = ln & 15, grp = ln >> 4, jl = grp >> 1, h = 8 * (grp & 1) + e, dd = part - jl;
        float val = 0.f;
        if (dd >= 0) {
            for (int p = 0; p < 64; ++p) { const float lr = lam[(dd * 64 + p) * 2], li = lam[(dd * 64 + p) * 2 + 1], cr = cc[(hh * 64 + p) * 2], ci = cc[(hh * 64 + p) * 2 + 1];
                const float tr = cr * lr - ci * li, ti = cr * li + ci * lr; val += tr * bb[(p * 16 + h) * 2] - ti * bb[(p * 16 + h) * 2 + 1]; }
            if (dd == 0 && hh == h) val += F.in[19][g * 16 + hh];
        }
        MFp[(part * 64 + ln) * 8 + e] = (bf16)f2bf(val);
    }
    if (part == 0) {
        { const int e = tid & 7, ln = tid >> 3, ko = ln & 15, grp = ln >> 4; WFp[ln * 8 + e] = (bf16)f2bf(e < 4 ? F.in[20][(size_t)(g * 16 + 4 * grp + e) * 16 + ko] : 0.f); }
        if (tid < 64) { const int p = tid; const float ar = F.in[12][g * 64 + p], ai = F.in[13][g * 64 + p];
            const float m8 = expf(ar * dt * 8.f), t8 = ai * dt * 8.f, m128 = expf(ar * dt * 128.f), t128 = ai * dt * 128.f;
            CSp[p] = m8 * cosf(t8); CSp[64 + p] = m8 * sinf(t8); CSp[128 + p] = m128 * cosf(t128); CSp[192 + p] = m128 * sinf(t128); }
        if (tid < 16) CSp[256 + tid] = F.in[21][g * 16 + tid];
    }
    __syncthreads();
}

template <int MODE>
__device__ __forceinline__ void ssm_block(LAS unsigned char* L, LAS unsigned char* scr, const bf16* ublk, int lane, float hb0, float hb1, LAS float* eb_out,
                                          const float* st_re, const float* st_im, float* so_re, float* so_im, int g, int db0, bf16* mix, float* ssq, int row0) {
    const int c = lane & 15, grp = lane >> 4;
    LAS const float* cst = (LAS const float*)(L + SC_CONST);
    s_bf16x8 ufr[4];
#pragma unroll
    for (int kk = 0; kk < 4; ++kk) ufr[kk] = *(const s_bf16x8*)(ublk + c * 128 + kk * 32 + grp * 8);
    s_f32x4 ev4[8];
#pragma unroll
    for (int mt = 0; mt < 8; ++mt) { s_f32x4 a = (s_f32x4){0.f, 0.f, 0.f, 0.f};
#pragma unroll
        for (int kk = 0; kk < 4; ++kk) a = __builtin_amdgcn_mfma_f32_16x16x32_bf16(*(LAS const s_bf16x8*)(L + SC_SF + ((mt * 4 + kk) * 64 + lane) * 16), ufr[kk], a, 0, 0, 0);
        ev4[mt] = a; }
    float hin[2][16];
#pragma unroll
    for (int hf = 0; hf < 2; ++hf) {
#pragma unroll
        for (int q = 0; q < 4; ++q) *(LAS s_f32x4*)(scr + c * 272 + (8 * q + 2 * grp) * 8) = ev4[4 * hf + q];
        asm volatile("s_waitcnt lgkmcnt(0)" ::: "memory");
        float ev[16];
#pragma unroll
        for (int k = 0; k < 16; ++k) ev[k] = *(LAS const float*)(scr + k * 272 + 4 * lane);
        const float ar = cst[32 * hf + (lane >> 1)], ai = cst[64 + 32 * hf + (lane >> 1)], coef = (lane & 1) ? ai : -ai;
        asm volatile("s_waitcnt lgkmcnt(0)" ::: "memory");
        if (MODE == 2) {
#pragma unroll
            for (int k = 0; k < 16; ++k) { const size_t si = (size_t)((db0 + k) * 32 + g) * 64 + 32 * hf + (lane >> 1);
                const float own = (lane & 1) ? st_im[si] : st_re[si]; hin[hf][k] = own; const float oth = __shfl_xor(own, 1);
                const float hend = ar * own + coef * oth + ev[k]; if (lane & 1) so_im[si] = hend; else so_re[si] = hend; }
        } else {
            float h = (MODE == 1) ? (hf ? hb1 : hb0) : 0.f;
#pragma unroll
            for (int k = 0; k < 16; ++k) { hin[hf][k] = h; const float oth = __shfl_xor(h, 1); h = ar * h + coef * oth + ev[k]; }
            if (MODE == 0) eb_out[64 * hf + lane] = h;
        }
    }
    if (MODE == 0) return;
#pragma unroll
    for (int hf = 0; hf < 2; ++hf)
#pragma unroll
        for (int k = 0; k < 16; ++k) *(LAS unsigned short*)(scr + k * 272 + (64 * hf + lane) * 2) = (unsigned short)f2bf(hin[hf][k]);
    asm volatile("s_waitcnt lgkmcnt(0)" ::: "memory");
    s_bf16x8 hfr[4];
#pragma unroll
    for (int kk = 0; kk < 4; ++kk) hfr[kk] = *(LAS const s_bf16x8*)(scr + c * 272 + 64 * kk + 16 * grp);
    asm volatile("s_waitcnt lgkmcnt(0)" ::: "memory");
    const s_bf16x8 wf = *(LAS const s_bf16x8*)(L + SC_WF + lane * 16);
    s_f32x4 binit;
#pragma unroll
    for (int r = 0; r < 4; ++r) binit[r] = cst[256 + 4 * grp + r];
#pragma unroll
    for (int s = 0; s < 8; ++s) {
        s_f32x4 y = (s_f32x4){0.f, 0.f, 0.f, 0.f};
#pragma unroll
        for (int kk = 0; kk < 4; ++kk) y = __builtin_amdgcn_mfma_f32_16x16x32_bf16(*(LAS const s_bf16x8*)(L + SC_RF + ((s * 4 + kk) * 64 + lane) * 16), hfr[kk], y, 0, 0, 0);
#pragma unroll
        for (int kk = 0; kk < 4; ++kk) if (2 * kk <= s) y = __builtin_amdgcn_mfma_f32_16x16x32_bf16(*(LAS const s_bf16x8*)(L + SC_MF + ((s - 2 * kk) * 64 + lane) * 16), ufr[kk], y, 0, 0, 0);
        float gl[4];
#pragma unroll
        for (int r = 0; r < 4; ++r) { const float x = y[r], z = 0.7978845608028654f * (x + 0.044715f * x * x * x); gl[r] = x * __builtin_amdgcn_rcpf(1.0f + __builtin_amdgcn_exp2f(-2.0f * LOG2E * z)); }
        v4u gw; gw.x = pk2(gl[0], gl[1]); gw.y = pk2(gl[2], gl[3]); gw.z = 0u; gw.w = 0u;
        const s_f32x4 gate = __builtin_amdgcn_mfma_f32_16x16x32_bf16(wf, __builtin_bit_cast(s_bf16x8, gw), binit, 0, 0, 0);
        float o[4], ss = 0.f;
#pragma unroll
        for (int r = 0; r < 4; ++r) { o[r] = gl[r] * __builtin_amdgcn_rcpf(1.0f + __builtin_amdgcn_exp2f(-LOG2E * gate[r])); ss += o[r] * o[r]; }
        ss += __shfl_xor(ss, 16); ss += __shfl_xor(ss, 32);
        const int row = (MODE == 2) ? (NROW_P + (db0 + c) * 8 + s) : (row0 + 8 * c + s);
        v2u w; w.x = pk2(o[0], o[1]); w.y = pk2(o[2], o[3]);
        *(v2u*)(mix + (size_t)row * DM + g * 16 + 4 * grp) = w;
        if (grp == 0) atomicAdd(ssq + row, ss);
    }
}

__device__ __forceinline__ void p2_ssm(Frame& F) {
    const int lane = F.lane, wave = F.wave, tid = F.tid;
    LAS unsigned char* L = F.lds + RING_OFF;
    LAS unsigned char* scr = L + SL_SCR + wave * SL_SCR_W;
    LAS float* EB = (LAS float*)(L + SL_EB);
    bf16* MIX = (bf16*)(F.ws + F.mix_off); float* ssq_ssm = (float*)(F.ws + F.ssq_off);
    const bf16 *U = WSP(bf16, WS_U), *Us = WSP(bf16, WS_US);
    for (int u = F.vcu; u < 256; u += F.G) {
        const int g = u & 31, b = u >> 5;
        __syncthreads();
        for (int i = tid; i < SC_BYTES / 16; i += NWAVES * 64) ((LAS v4u*)L)[i] = ((const v4u*)(F.ws + WS_SSMC + (size_t)g * SSMC_STRIDE))[i];
        __syncthreads();
        const bf16* ub = U + (size_t)(g * 8 + b) * KVS * 16;
#pragma unroll 1
        for (int i = wave; i < 33; i += NWAVES)
            ssm_block<0>(L, scr, ub + (size_t)i * 128 * 16, lane, 0.f, 0.f, EB + i * 128, nullptr, nullptr, nullptr, nullptr, g, 0, nullptr, nullptr, 0);
        __syncthreads();
        LAS const float* cst = (LAS const float*)(L + SC_CONST);
        float hbin[4][2];
#pragma unroll
        for (int hf = 0; hf < 2; ++hf) {
            const float ar = cst[128 + 32 * hf + (lane >> 1)], ai = cst[192 + 32 * hf + (lane >> 1)], coef = (lane & 1) ? ai : -ai;
            float h = 0.f;
#pragma unroll
            for (int k = 0; k < 4; ++k) hbin[k][hf] = 0.f;
#pragma unroll 1
            for (int i = 0; i < 33; ++i) {
#pragma unroll
                for (int k = 0; k < 4; ++k) hbin[k][hf] = (i == 1 + wave + 8 * k) ? h : hbin[k][hf];
                const float oth = __shfl_xor(h, 1); h = ar * h + coef * oth + EB[i * 128 + 64 * hf + lane];
            }
            if (wave == 0) F.out[((lane & 1) ? O_SIP : O_SRP) + (size_t)(b * 32 + g) * 64 + 32 * hf + (lane >> 1)] = h;
        }
#pragma unroll
        for (int k = 0; k < 4; ++k) { const int i = 1 + wave + 8 * k;
            ssm_block<1>(L, scr, ub + (size_t)i * 128 * 16, lane, hbin[k][0], hbin[k][1], nullptr, nullptr, nullptr, nullptr, nullptr, g, 0, MIX, ssq_ssm, b * SEQ + 128 * (i - 1)); }
        if (wave == 7) ssm_block<2>(L, scr, Us + ((size_t)g * 1024 + b * 128) * 16, lane, 0.f, 0.f, nullptr, F.in[4], F.in[5], F.out + O_SRS, F.out + O_SIS, g, 16 * b, MIX, ssq_ssm, 0);
    }
    __syncthreads();
}

typedef short a_bf16x8 __attribute__((ext_vector_type(8)));
typedef float a_f32x16 __attribute__((ext_vector_type(16)));
constexpr int ATT_K_OFF = 0, ATT_V_OFF = 40960, ATT_VS_P = 520, ATT_VS_S = 328;
__device__ __forceinline__ unsigned cvtpk(float lo, float hi) { unsigned r; asm volatile("v_cvt_pk_bf16_f32 %0, %1, %2" : "=v"(r) : "v"(lo), "v"(hi)); return r; }

template <class MaskF>
__device__ __forceinline__ void attn_item(const bf16* qrow, LAS const unsigned char* Kimg, int krow0, LAS const unsigned char* Vt, int vstride, int vkey0, float sink2, MaskF mask,
                                          bf16* orow, float* ssqp, int lane) {
    const int c = lane & 31, hh = lane >> 5;
    a_bf16x8 qf[4];
#pragma unroll
    for (int ks = 0; ks < 4; ++ks) qf[ks] = *(const a_bf16x8*)(qrow + 16 * ks + 8 * hh);
    a_f32x16 st[5];
#pragma unroll
    for (int t = 0; t < 5; ++t) {
        const int row = krow0 + 32 * t + c;
        LAS const unsigned char* kr = Kimg + row * 128;
#pragma unroll
        for (int r = 0; r < 16; ++r) st[t][r] = 0.f;
#pragma unroll
        for (int ks = 0; ks < 4; ++ks) {
            const a_bf16x8 kf = *(LAS const a_bf16x8*)(kr + (((2 * ks + hh) ^ (row & 7)) << 4));
            st[t] = __builtin_amdgcn_mfma_f32_32x32x16_bf16(kf, qf[ks], st[t], 0, 0, 0);
        }
    }
    float mx = sink2;
#pragma unroll
    for (int t = 0; t < 5; ++t)
#pragma unroll
        for (int r = 0; r < 16; ++r) { const int kin = (r & 3) + 8 * (r >> 2) + 4 * hh; const float v = mask(t, kin, c) ? st[t][r] : -INFINITY; st[t][r] = v; mx = fmaxf(mx, v); }
    mx = fmaxf(mx, __shfl_xor(mx, 32));
    float l = 0.f;
#pragma unroll
    for (int t = 0; t < 5; ++t)
#pragma unroll
        for (int r = 0; r < 16; ++r) { const float p = __builtin_amdgcn_exp2f(st[t][r] - mx); st[t][r] = p; l += p; }
    l += __shfl_xor(l, 32);
    l += __builtin_amdgcn_exp2f(sink2 - mx);
    a_f32x16 o[2];
#pragma unroll
    for (int r = 0; r < 16; ++r) { o[0][r] = 0.f; o[1][r] = 0.f; }
#pragma unroll
    for (int t = 0; t < 5; ++t)
#pragma unroll
        for (int s = 0; s < 2; ++s) {
            v4u pw; pw.x = cvtpk(st[t][8 * s + 0], st[t][8 * s + 1]); pw.y = cvtpk(st[t][8 * s + 2], st[t][8 * s + 3]); pw.z = cvtpk(st[t][8 * s + 4], st[t][8 * s + 5]); pw.w = cvtpk(st[t][8 * s + 6], st[t][8 * s + 7]);
            const a_bf16x8 pf = __builtin_bit_cast(a_bf16x8, pw);
#pragma unroll
            for (int dt = 0; dt < 2; ++dt) {
                LAS const unsigned char* vb = Vt + (32 * dt + c) * vstride + (vkey0 + 32 * t + 16 * s + 4 * hh) * 2;
                const v2u lo = *(LAS const v2u*)(vb), hi = *(LAS const v2u*)(vb + 16);
                v4u aw; aw.x = lo.x; aw.y = lo.y; aw.z = hi.x; aw.w = hi.y;
                o[dt] = __builtin_amdgcn_mfma_f32_32x32x16_bf16(__builtin_bit_cast(a_bf16x8, aw), pf, o[dt], 0, 0, 0);
            }
        }
    const float inv = 1.0f / l;
    float ss = 0.f;
#pragma unroll
    for (int dt = 0; dt < 2; ++dt)
#pragma unroll
        for (int rg = 0; rg < 4; ++rg) {
            const float a0 = o[dt][4 * rg] * inv, a1 = o[dt][4 * rg + 1] * inv, a2 = o[dt][4 * rg + 2] * inv, a3 = o[dt][4 * rg + 3] * inv;
            ss += (a0 * a0 + a1 * a1) + (a2 * a2 + a3 * a3);
            v2u w; w.x = cvtpk(a0, a1); w.y = cvtpk(a2, a3);
            *(v2u*)(orow + 32 * dt + 8 * rg + 4 * hh) = w;
        }
    ss += __shfl_xor(ss, 32);
    if (hh == 0) atomicAdd(ssqp, ss);
}

__device__ __forceinline__ void p2_attn(Frame& F) {
    const int lane = F.lane, wave = F.wave, tid = F.tid;
    const bf16 *Q = WSP(bf16, WS_Q), *Kp = WSP(bf16, WS_KP), *Vp = WSP(bf16, WS_VP), *Ks = WSP(bf16, WS_KS), *Vs = WSP(bf16, WS_VS);
    bf16* MIX = (bf16*)(F.ws + F.mix_off); float* ssq_att = (float*)(F.ws + F.ssq_off) + NROW;
    LAS unsigned char* Kimg = F.lds + RING_OFF + ATT_K_OFF; LAS unsigned char* Vimg = F.lds + RING_OFF + ATT_V_OFF;
    for (int u = F.vcu; u < 512 + DECB; u += F.G) {
        if (u < 512) {
            const int b = u >> 6, qb = (u >> 1) & 31, kvh = u & 1;
            const bf16* kg = Kp + (size_t)(b * KVS + 128 * qb) * 128 + kvh * 64; const bf16* vg = Vp + (size_t)(b * KVS + 128 * qb) * 128 + kvh * 64;
#pragma unroll
            for (int j = 0; j < 4; ++j) { const int pi = tid + 512 * j, row = pi >> 3, ch = pi & 7;
                const v4u kv = *(const v4u*)(kg + (size_t)row * 128 + ch * 8); *(LAS v4u*)(Kimg + row * 128 + ((ch ^ (row & 7)) << 4)) = kv;
                const v4u vv = *(const v4u*)(vg + (size_t)row * 128 + ch * 8);
                LAS unsigned short* vt = (LAS unsigned short*)(Vimg + (8 * ch) * ATT_VS_P + row * 2);
                vt[0 * (ATT_VS_P / 2)] = (unsigned short)(vv.x & 0xffffu); vt[1 * (ATT_VS_P / 2)] = (unsigned short)(vv.x >> 16);
                vt[2 * (ATT_VS_P / 2)] = (unsigned short)(vv.y & 0xffffu); vt[3 * (ATT_VS_P / 2)] = (unsigned short)(vv.y >> 16);
                vt[4 * (ATT_VS_P / 2)] = (unsigned short)(vv.z & 0xffffu); vt[5 * (ATT_VS_P / 2)] = (unsigned short)(vv.z >> 16);
                vt[6 * (ATT_VS_P / 2)] = (unsigned short)(vv.w & 0xffffu); vt[7 * (ATT_VS_P / 2)] = (unsigned short)(vv.w >> 16); }
            __syncthreads();
#pragma unroll 1
            for (int k = 0; k < 2; ++k) {
                const int idx = wave + 8 * k, hq = idx & 3, sb = idx >> 2, h = 4 * kvh + hq;
                const int row = b * SEQ + 128 * qb + 32 * sb + (lane & 31);
                const int rho0 = 128 * qb + 32 * sb;
                auto mask = [=](int t, int kin, int c) { const int kr = 32 * t + kin; return (kr >= c) && (kr <= c + WIN) && (rho0 + kr >= 112); };
                attn_item(Q + (size_t)row * 512 + h * 64, Kimg, 32 * sb, Vimg, ATT_VS_P, 32 * sb, F.in[11][h] * LOG2E, mask, MIX + (size_t)row * DM + 512 + h * 64, ssq_att + row, lane);
            }
            __syncthreads();
        } else {
            const int db = u - 512;
            for (int pi = tid; pi < 2 * 160 * 8; pi += NWAVES * 64) {
                const int ch = pi & 7, rj = pi >> 3, kvh = rj / 160, j = rj % 160;
                v4u kv = (v4u){0u, 0u, 0u, 0u}, vv = (v4u){0u, 0u, 0u, 0u};
                if (j < WIN) { const v4f* kp = (const v4f*)(F.in[2] + ((size_t)(db * WIN + j) * 2 + kvh) * 64 + ch * 8); const v4f* vp = (const v4f*)(F.in[3] + ((size_t)(db * WIN + j) * 2 + kvh) * 64 + ch * 8);
                    const v4f k0 = kp[0], k1 = kp[1], v0 = vp[0], v1 = vp[1];
                    kv.x = pk2(k0.x, k0.y); kv.y = pk2(k0.z, k0.w); kv.z = pk2(k1.x, k1.y); kv.w = pk2(k1.z, k1.w);
                    vv.x = pk2(v0.x, v0.y); vv.y = pk2(v0.z, v0.w); vv.z = pk2(v1.x, v1.y); vv.w = pk2(v1.z, v1.w); }
                else if (j < WIN + DECS) { kv = *(const v4u*)(Ks + (size_t)(db * 8 + j - WIN) * 128 + kvh * 64 + ch * 8); vv = *(const v4u*)(Vs + (size_t)(db * 8 + j - WIN) * 128 + kvh * 64 + ch * 8); }
                *(LAS v4u*)(Kimg + rj * 128 + ((ch ^ (rj & 7)) << 4)) = kv;
                LAS unsigned short* vt = (LAS unsigned short*)(Vimg + (kvh * 64 + 8 * ch) * ATT_VS_S + j * 2);
                vt[0 * (ATT_VS_S / 2)] = (unsigned short)(vv.x & 0xffffu); vt[1 * (ATT_VS_S / 2)] = (unsigned short)(vv.x >> 16);
                vt[2 * (ATT_VS_S / 2)] = (unsigned short)(vv.y & 0xffffu); vt[3 * (ATT_VS_S / 2)] = (unsigned short)(vv.y >> 16);
                vt[4 * (ATT_VS_S / 2)] = (unsigned short)(vv.z & 0xffffu); vt[5 * (ATT_VS_S / 2)] = (unsigned short)(vv.z >> 16);
                vt[6 * (ATT_VS_S / 2)] = (unsigned short)(vv.w & 0xffffu); vt[7 * (ATT_VS_S / 2)] = (unsigned short)(vv.w >> 16);
            }
            __syncthreads();
            if (wave < 2) {
                const int kvh = wave, c = lane & 31, hq = c >> 3, s = c & 7, h = 4 * kvh + hq;
                const int row = NROW_P + db * 8 + s;
                auto mask = [=](int t, int kin, int cc) { const int j = 32 * t + kin, s2 = cc & 7; return (j >= s2) && (j <= s2 + WIN) && (j < WIN + DECS); };
                attn_item(Q + (size_t)row * 512 + h * 64, Kimg, kvh * 160, Vimg + kvh * 64 * ATT_VS_S, ATT_VS_S, 0, F.in[11][h] * LOG2E, mask, MIX + (size_t)row * DM + 512 + h * 64, ssq_att + row, lane);
            }
            __syncthreads();
        }
    }
    {
        const int gw = F.vcu * NWAVES + F.wave, NGW = F.G * NWAVES;
        const int gt = gw * 64 + lane, NT = NGW * 64;
        for (int i2 = gt; i2 < NBATCH * WIN * 128; i2 += NT) { const int b = i2 >> 14, w = (i2 >> 7) & 127, c = i2 & 127;
            F.out[O_KWP + i2] = bf2f(Kp[(size_t)(b * KVS + 4096 + w) * 128 + c]); F.out[O_VWP + i2] = bf2f(Vp[(size_t)(b * KVS + 4096 + w) * 128 + c]); }
        for (int i2 = gt; i2 < DECB * DECS * 128; i2 += NT) { const int db = i2 >> 10, s = (i2 >> 7) & 7, c = i2 & 127;
            F.out[O_KWS + (size_t)db * 16384 + (120 + s) * 128 + c] = bf2f(Ks[i2]); F.out[O_VWS + (size_t)db * 16384 + (120 + s) * 128 + c] = bf2f(Vs[i2]); }
    }
}

__device__ __forceinline__ void tr_item(const float* W, int ldw, int src_k0, int src_n0, const float* kscale, bf16* WT, int ldwt, int dst_n0, int dst_k0, LAS float* scr, int lane) {
#pragma unroll 8
    for (int i = 0; i < 32; ++i) { const int kk = 2 * i + (lane >> 5); float v = W[(size_t)(src_k0 + kk) * ldw + src_n0 + (lane & 31)]; if (kscale) v *= kscale[kk]; scr[kk * 33 + (lane & 31)] = v; }
    LDS_WAIT(); asm volatile("" ::: "memory");
    const int c = lane & 7;
#pragma unroll
    for (int j = 0; j < 4; ++j) { const int n = (lane >> 3) + 8 * j; const LAS float* s = scr + (8 * c) * 33 + n;
        v4u o; o.x = pk2(s[0 * 33], s[1 * 33]); o.y = pk2(s[2 * 33], s[3 * 33]); o.z = pk2(s[4 * 33], s[5 * 33]); o.w = pk2(s[6 * 33], s[7 * 33]);
        *(GAS v4u*)(WT + (size_t)(dst_n0 + n) * ldwt + dst_k0 + 8 * c) = o; }
    LDS_WAIT(); asm volatile("" ::: "memory");
}
__device__ __forceinline__ void p0_prologue(Frame& F) {
    for (int it = F.vcu; it < 256; it += F.G) p0_ssm_consts(F, it & 31, it >> 5);
    LAS float* scr = (LAS float*)(F.lds + RING_OFF + F.wave * 16384);
    const int gw = F.vcu * NWAVES + F.wave, NGW = F.G * NWAVES, lane = F.lane;
    constexpr int I_IN = 16 * 40, I_O = 16 * 32, I_GU = 16 * 176, I_D = 44 * 32, NITEMS = I_IN + I_O + I_GU + I_D;
    for (int it = gw; it < NITEMS; it += NGW) {
        int r = it;
        if (r < I_IN) { const int kb = r / 40, nb = r % 40, n0 = 32 * nb; int s0 = n0;
            if (n0 < 768) { const int pn = n0 >> 8, ct = n0 & 255; s0 = 256 * pn + 64 * ((ct & 127) >> 5) + 32 * (ct >> 7); }
            tr_item(F.in[8], INC, 64 * kb, s0, nullptr, WSP(bf16, WS_WIN), DM, n0, 64 * kb, scr, lane); continue; }
        r -= I_IN;
        if (r < I_O) { const int kb = r / 32, nb = r % 32, k0 = 64 * kb;
            const int sk = k0 < 512 ? k0 + 512 : k0 - 512; const float* ks = k0 < 512 ? F.in[23] + k0 : F.in[22] + (k0 - 512);
            tr_item(F.in[24], DM, sk, 32 * nb, ks, WSP(bf16, WS_WO), DM, 32 * nb, k0, scr, lane); continue; }
        r -= I_O;
        if (r < I_GU) { const int kb = r / 176, nb = r % 176, n0 = 32 * nb, pn = n0 >> 8, ct = n0 & 255;
            const float* W = ct < 128 ? F.in[26] : F.in[27];
            tr_item(W, DFF, 64 * kb, 128 * pn + (ct & 127), F.in[25] + 64 * kb, WSP(bf16, WS_WGU), DM, n0, 64 * kb, scr, lane); continue; }
        r -= I_GU;
        { const int kb = r / 32, nb = r % 32; tr_item(F.in[28], DM, 64 * kb, 32 * nb, nullptr, WSP(bf16, WS_WD), DFF, 32 * nb, 64 * kb, scr, lane); }
    }
    {
        const GAS v4f* gp = (const GAS v4f*)F.in[7] + lane;
        v4f g[4];
#pragma unroll
        for (int j = 0; j < 4; ++j) g[j] = gp[64 * j];
        bf16* XN = WSP(bf16, WS_XN);
        for (int r = gw; r < NROW_IN; r += NGW) {
            GAS unsigned long long* o8 = (GAS unsigned long long*)(XN + (size_t)r * DM) + lane;
            if (r >= ROW_META + NMETA) {
#pragma unroll
                for (int j = 0; j < 4; ++j) o8[64 * j] = 0ull;
                continue;
            }
            const float* xrow = r < NROW_P ? F.in[0] + (size_t)r * DM : (r < NROW ? F.in[1] + (size_t)(r - NROW_P) * DM : F.in[6] + (size_t)(r - NROW) * DM);
            const GAS v4f* xr = (const GAS v4f*)xrow + lane;
            v4f v[4]; float s = 0.f;
#pragma unroll
            for (int j = 0; j < 4; ++j) { v[j] = xr[64 * j]; s += (v[j].x * v[j].x + v[j].y * v[j].y) + (v[j].z * v[j].z + v[j].w * v[j].w); }
            const float rstd = rsqrtf(wave_sum(s) * (1.f / DM) + EPS);
#pragma unroll
            for (int j = 0; j < 4; ++j) { const v4f y = v[j] * g[j] * rstd; o8[64 * j] = (unsigned long long)pk2(y.x, y.y) | ((unsigned long long)pk2(y.z, y.w) << 32); }
        }
    }
    {
        const int gt = gw * 64 + lane, NT = NGW * 64;
        GAS v4f* ssq = (GAS v4f*)WSP(float, WS_SSQ);
        for (int i = gt; i < 3 * NROW / 4; i += NT) ssq[i] = (v4f){0.f, 0.f, 0.f, 0.f};
        for (int i = gt; i < 256 * 224; i += NT) { const int gb = i / 224, w = i % 224; *(GAS v4u*)(F.ws + WS_U + (size_t)gb * KVS * 32 + (size_t)w * 16) = (v4u){0u, 0u, 0u, 0u}; }
        for (int i = gt; i < 8 * 1792; i += NT) { const int b = i / 1792, w = i % 1792;
            *(GAS v4u*)(F.ws + WS_KP + (size_t)b * KVS * 256 + (size_t)w * 16) = (v4u){0u, 0u, 0u, 0u}; *(GAS v4u*)(F.ws + WS_VP + (size_t)b * KVS * 256 + (size_t)w * 16) = (v4u){0u, 0u, 0u, 0u}; }
        for (int i = gt; i < DECB * 3840; i += NT) { const int db = i / 3840, w = i % 3840;
            ((GAS v4f*)(F.out + O_KWS + (size_t)db * 16384))[w] = ((const GAS v4f*)(F.in[2] + (size_t)db * 16384 + 1024))[w];
            ((GAS v4f*)(F.out + O_VWS + (size_t)db * 16384))[w] = ((const GAS v4f*)(F.in[3] + (size_t)db * 16384 + 1024))[w]; }
    }
}

__device__ __forceinline__ void unpack8(const v4u w, float* f) { f[0] = bflo(w.x); f[1] = bfhi(w.x); f[2] = bflo(w.y); f[3] = bfhi(w.y); f[4] = bflo(w.z); f[5] = bfhi(w.z); f[6] = bflo(w.w); f[7] = bfhi(w.w); }
__device__ __forceinline__ void p2_simple_attn(Frame& F) {
    LAS float* pw = (LAS float*)(F.lds + RING_OFF) + F.wave * 192;
    const int gw = F.vcu * NWAVES + F.wave, NGW = F.G * NWAVES, lane = F.lane;
    const bf16 *Q = WSP(bf16, WS_Q), *Kp = WSP(bf16, WS_KP), *Vp = WSP(bf16, WS_VP), *Ks = WSP(bf16, WS_KS), *Vs = WSP(bf16, WS_VS);
    bf16* MIX = WSP(bf16, WS_MIX); float* ssq_att = WSP(float, WS_SSQ) + NROW;
    const float *ck = F.in[2], *cv = F.in[3];
    for (int it = gw; it < NROW * NHQ; it += NGW) {
        const int r = it >> 3, h = it & 7, kvh = h >> 2;
        float q[64];
        { const v4u* qp = (const v4u*)(Q + (size_t)r * 512 + h * 64);
#pragma unroll
          for (int j = 0; j < 8; ++j) unpack8(qp[j], q + 8 * j); }
        const float sink = F.in[11][h] * LOG2E;
        const bool prompt = r < NROW_P;
        const int b = r >> 12, i = r & 4095, sr = r - NROW_P, db = sr >> 3, s = sr & 7;
        float sc[3];
#pragma unroll
        for (int rnd = 0; rnd < 3; ++rnd) {
            const int jj = lane + 64 * rnd; bool valid = jj <= WIN; const int jc = valid ? jj : 0; float d = 0.f;
            if (prompt) {
                const int rho = i + jc; valid = valid && (rho >= 112);
                const v4u* kp = (const v4u*)(Kp + (size_t)(b * KVS + rho) * 128 + kvh * 64);
#pragma unroll
                for (int j = 0; j < 8; ++j) { float kf[8]; unpack8(kp[j], kf);
#pragma unroll
                    for (int e = 0; e < 8; ++e) d += q[8 * j + e] * kf[e]; }
            } else {
                const int j2 = s + jc;
                if (j2 < WIN) { const v4f* kp = (const v4f*)(ck + ((size_t)(db * WIN + j2) * 2 + kvh) * 64);
#pragma unroll
                    for (int j = 0; j < 16; ++j) { const v4f kf = kp[j]; d += q[4 * j] * kf.x + q[4 * j + 1] * kf.y + q[4 * j + 2] * kf.z + q[4 * j + 3] * kf.w; } }
                else { const v4u* kp = (const v4u*)(Ks + (size_t)(db * 8 + (j2 - WIN)) * 128 + kvh * 64);
#pragma unroll
                    for (int j = 0; j < 8; ++j) { float kf[8]; unpack8(kp[j], kf);
#pragma unroll
                        for (int e = 0; e < 8; ++e) d += q[8 * j + e] * kf[e]; } }
            }
            sc[rnd] = valid ? d : -INFINITY;
        }
        float m = wave_max(fmaxf(fmaxf(sc[0], sc[1]), sc[2])); m = fmaxf(m, sink);
        float psum = 0.f;
#pragma unroll
        for (int rnd = 0; rnd < 3; ++rnd) { const float p = __builtin_amdgcn_exp2f(sc[rnd] - m); psum += p; pw[lane + 64 * rnd] = p; }
        const float denom = wave_sum(psum) + __builtin_amdgcn_exp2f(sink - m);
        LDS_WAIT(); asm volatile("" ::: "memory");
        float o = 0.f;
        if (prompt) {
            const bf16* vp = Vp + (size_t)(b * KVS + i) * 128 + kvh * 64 + lane;
            for (int jj = 0; jj <= WIN; ++jj) o += pw[jj] * bf2f(vp[(size_t)jj * 128]);
        } else {
            for (int jj = 0; jj <= WIN; ++jj) { const int j2 = s + jj;
                const float v = j2 < WIN ? cv[((size_t)(db * WIN + j2) * 2 + kvh) * 64 + lane] : bf2f(Vs[(size_t)(db * 8 + (j2 - WIN)) * 128 + kvh * 64 + lane]);
                o += pw[jj] * v; }
        }
        o = o / denom;
        MIX[(size_t)r * DM + 512 + h * 64 + lane] = (bf16)f2bf(o);
        const float ss = wave_sum(o * o);
        if (lane == 0) atomicAdd(ssq_att + r, ss);
        LDS_WAIT(); asm volatile("" ::: "memory");
    }
    {
        const int gt = gw * 64 + lane, NT = NGW * 64;
        for (int i2 = gt; i2 < NBATCH * WIN * 128; i2 += NT) { const int b = i2 >> 14, w = (i2 >> 7) & 127, c = i2 & 127;
            F.out[O_KWP + i2] = bf2f(Kp[(size_t)(b * KVS + 4096 + w) * 128 + c]); F.out[O_VWP + i2] = bf2f(Vp[(size_t)(b * KVS + 4096 + w) * 128 + c]); }
        for (int i2 = gt; i2 < DECB * DECS * 128; i2 += NT) { const int db = i2 >> 10, s = (i2 >> 7) & 7, c = i2 & 127;
            F.out[O_KWS + (size_t)db * 16384 + (120 + s) * 128 + c] = bf2f(Ks[i2]); F.out[O_VWS + (size_t)db * 16384 + (120 + s) * 128 + c] = bf2f(Vs[i2]); }
    }
}
__device__ __forceinline__ void p2_simple_ssm(Frame& F) {
    const int gw = F.vcu * NWAVES + F.wave, NGW = F.G * NWAVES, lane = F.lane, p = lane;
    const bf16 *U = WSP(bf16, WS_U), *Us = WSP(bf16, WS_US);
    bf16* MIX = WSP(bf16, WS_MIX); float* ssq_ssm = WSP(float, WS_SSQ);
    for (int it = gw; it < 256 + NG * DECB; it += NGW) {
        const bool prompt = it < 256; const int g = prompt ? (it & 31) : ((it - 256) & 31), bb = prompt ? (it >> 5) : ((it - 256) >> 5);
        const float dt = expf(F.in[14][g]), ar = F.in[12][g * 64 + p], ai = F.in[13][g * 64 + p];
        const float th = ai * dt, mag = expf(ar * dt), cs = cosf(th), sn = sinf(th), lr = mag * cs, li = mag * sn;
        const float sh = sinf(0.5f * th), nr = expm1f(ar * dt) * cs - 2.f * sh * sh, ni = li, den = ar * ar + ai * ai;
        const float fr_ = (nr * ar + ni * ai) / den, fi_ = (ni * ar - nr * ai) / den;
        float bbr[16], bbi[16], cr[16], ci[16], dsk[16], wk[16];
#pragma unroll
        for (int h = 0; h < 16; ++h) { const float br = F.in[15][(size_t)(g * 64 + p) * 16 + h], bi = F.in[16][(size_t)(g * 64 + p) * 16 + h];
            bbr[h] = fr_ * br - fi_ * bi; bbi[h] = fr_ * bi + fi_ * br;
            cr[h] = F.in[17][(size_t)(g * 16 + h) * 64 + p]; ci[h] = F.in[18][(size_t)(g * 16 + h) * 64 + p];
            dsk[h] = F.in[19][g * 16 + h]; wk[h] = F.in[20][(size_t)(g * 16 + h) * 16 + (lane & 15)]; }
        const float bg = F.in[21][g * 16 + (lane & 15)];
        float hr = 0.f, hi = 0.f;
        if (!prompt) { hr = F.in[4][(size_t)(bb * 32 + g) * 64 + p]; hi = F.in[5][(size_t)(bb * 32 + g) * 64 + p]; }
        const int ntok = prompt ? (NMETA + SEQ) : DECS;
        const bf16* ubase = prompt ? U + ((size_t)(g * 8 + bb) * KVS + 112) * 16 : Us + ((size_t)g * 1024 + bb * 8) * 16;
        for (int t = 0; t < ntok; ++t) {
            const v4u* up = (const v4u*)(ubase + (size_t)t * 16);
            float u[16]; unpack8(up[0], u); unpack8(up[1], u + 8);
            float xr = 0.f, xi = 0.f;
#pragma unroll
            for (int h = 0; h < 16; ++h) { xr += bbr[h] * u[h]; xi += bbi[h] * u[h]; }
            const float nhr = lr * hr - li * hi + xr, nhi = lr * hi + li * hr + xi; hr = nhr; hi = nhi;
            float gl[16];
#pragma unroll
            for (int h = 0; h < 16; ++h) { const float y = wave_sum(cr[h] * hr - ci[h] * hi) + dsk[h] * u[h]; gl[h] = gelu_tanh(y); }
            float gate = bg, glk = 0.f;
#pragma unroll
            for (int h = 0; h < 16; ++h) { gate += gl[h] * wk[h]; glk = ((lane & 15) == h) ? gl[h] : glk; }
            const float o = glk * sigmoidf_(gate);
            float ss = o * o; ss += __shfl_xor(ss, 1); ss += __shfl_xor(ss, 2); ss += __shfl_xor(ss, 4); ss += __shfl_xor(ss, 8);
            const int row = prompt ? (t >= NMETA ? bb * SEQ + t - NMETA : -1) : NROW_P + bb * 8 + t;
            if (row >= 0 && lane < 16) { MIX[(size_t)row * DM + g * 16 + lane] = (bf16)f2bf(o); if (lane == 0) atomicAdd(ssq_ssm + row, ss); }
        }
        if (prompt) { F.out[O_SRP + (size_t)(bb * 32 + g) * 64 + p] = hr; F.out[O_SIP + (size_t)(bb * 32 + g) * 64 + p] = hi; }
        else { F.out[O_SRS + (size_t)(bb * 32 + g) * 64 + p] = hr; F.out[O_SIS + (size_t)(bb * 32 + g) * 64 + p] = hi; }
    }
}

struct Args { const float* in[29]; float* out; unsigned char* ws; int ph_lo, ph_hi; };
__global__ void __launch_bounds__(NWAVES * 64, 2) hymba_fwd(Args args) {
    extern __shared__ __attribute__((aligned(16))) unsigned char lds[];
    Frame F;
    F.lds = (LAS unsigned char*)lds;
    F.MISC = (volatile LAS unsigned*)(F.lds + MISC_OFF);
    F.tid = threadIdx.x; F.lane = F.tid & 63; F.wave = __builtin_amdgcn_readfirstlane(F.tid >> 6);
    F.G = gridDim.x; { const int bx = blockIdx.x; F.vcu = (F.G % 8 == 0) ? (bx % 8) * (F.G / 8) + bx / 8 : bx; }
    F.ws = args.ws; F.out = args.out; F.mix_off = WS_MIX; F.ssq_off = WS_SSQ; F.ctl = (gu32*)(args.ws + WS_CTL);
#pragma unroll
    for (int i = 0; i < 29; ++i) F.in[i] = args.in[i];
    for (int u = F.tid; u < (LDS_BYTES - LDSCTL_OFF) / 4; u += NWAVES * 64) ((LAS unsigned*)(F.lds + LDSCTL_OFF))[u] = 0u;
    __syncthreads();
    XcdBarrier bar; bar.bar = (unsigned*)(F.ctl + CW_BAR); bar.x = 0; bar.st = nullptr;
    if (N_LAUNCHES != PER_PHASE) bar = xcd_barrier_post((unsigned*)(F.ctl + CW_BAR), F.MISC + 8);
#define GRID_BAR() do { if (N_LAUNCHES != PER_PHASE) xcd_barrier(bar); } while (0)
    const int lo = args.ph_lo, hi = args.ph_hi;
#define IN(k) (lo <= (k) && (k) < hi)
#define BOTH(k) (IN(k) && IN((k) + 1))

    if (IN(0)) { if (PROBE_DUP == 0) { p0_prologue(F); __syncthreads(); } p0_prologue(F); if (BOTH(0)) GRID_BAR(); }

    const pg8::EpiAll E{F.ws, F.out, F.in[0], F.in[1], F.in[9], F.in[10]};
    if (IN(1)) {
        pg8::StreamOrder S; S.init1(F.G, F.vcu, 1, NROW_IN / 256, INC / 256, F.ws, (unsigned*)F.ctl);
        if (PROBE_DUP == 1) pg8::gemm_stream(F.lds + RING_OFF, S, E);
        pg8::gemm_stream(F.lds + RING_OFF, S, E);
        if (BOTH(1)) GRID_BAR();
    }

    if (IN(2)) { if (PROBE_DUP == 2) { F.mix_off = WS_DUMMY; F.ssq_off = WS_DUMMY + 100 * MiB; p2_ssm(F); p2_attn(F); F.mix_off = WS_MIX; F.ssq_off = WS_SSQ; } p2_ssm(F); p2_attn(F); if (BOTH(2)) GRID_BAR(); }

#if MK_MERGE345
    if (IN(3)) {
        pg8::StreamOrder S; S.init345(F.G, F.vcu, F.ws, (unsigned*)F.ctl);
        pg8::gemm_stream(F.lds + RING_OFF, S, E);
    }
#else
    if (IN(3)) {
        pg8::StreamOrder S; S.init1(F.G, F.vcu, 3, NROW / 256, DM / 256, F.ws, (unsigned*)F.ctl);
        pg8::gemm_stream(F.lds + RING_OFF, S, E);
        if (BOTH(3)) GRID_BAR();
    }
    if (IN(4)) {
        pg8::StreamOrder S; S.init1(F.G, F.vcu, 4, NROW / 256, NGU / 256, F.ws, (unsigned*)F.ctl);
        pg8::gemm_stream(F.lds + RING_OFF, S, E);
        if (BOTH(4)) GRID_BAR();
    }
    if (IN(5)) {
        pg8::StreamOrder S; S.init1(F.G, F.vcu, 5, NROW / 256, DM / 256, F.ws, (unsigned*)F.ctl);
        pg8::gemm_stream(F.lds + RING_OFF, S, E);
    }
#endif
#undef IN
#undef BOTH
}

extern "C" void kernel_launch(void* const* d_in, const int* in_sizes, int n_in, void* d_out, int out_size, void* d_ws, size_t ws_size, hipStream_t stream) {
    static int grid = 0;
    if (grid == 0) {
        if (n_in != 29 || out_size != (int)O_END || ws_size < WS_END) { fprintf(stderr, "kernel_launch: unexpected shapes: n_in %d out %d ws %zu; nothing launched\n", n_in, out_size, ws_size); grid = -1; return; }
        int dev = 0, cus = 0, per_cu = 0;
        if (hipGetDevice(&dev) != hipSuccess || hipDeviceGetAttribute(&cus, hipDeviceAttributeMultiprocessorCount, dev) != hipSuccess) { grid = -1; return; }
        if (hipFuncSetAttribute((const void*)hymba_fwd, hipFuncAttributeMaxDynamicSharedMemorySize, LDS_BYTES) != hipSuccess) { fprintf(stderr, "kernel_launch: hipFuncSetAttribute failed\n"); grid = -1; return; }
        if (hipOccupancyMaxActiveBlocksPerMultiprocessor(&per_cu, (const void*)hymba_fwd, NWAVES * 64, LDS_BYTES) != hipSuccess || per_cu < 1)
            fprintf(stderr, "kernel_launch: note: occupancy query reports %d workgroups per CU\n", per_cu);
        (void)hipGetLastError();
        grid = cus;
    }
    if (grid < 0) return;
    if (hipMemsetAsync((char*)d_ws + WS_CTL, 0, CTL_ZERO_BYTES, stream) != hipSuccess) { fprintf(stderr, "kernel_launch: hipMemsetAsync failed\n"); return; }
    Args a{};
    for (int i = 0; i < 29; ++i) a.in[i] = (const float*)d_in[i];
    a.out = (float*)d_out; a.ws = (unsigned char*)d_ws;
    if (N_LAUNCHES == 1) {
        a.ph_lo = 0; a.ph_hi = PER_PHASE;
        hipLaunchKernelGGL(hymba_fwd, dim3(grid), dim3(NWAVES * 64), LDS_BYTES, stream, a);
    } else {
        for (int li = 0; li < PER_PHASE; ++li) { a.ph_lo = li; a.ph_hi = li + 1; hipLaunchKernelGGL(hymba_fwd, dim3(grid), dim3(NWAVES * 64), LDS_BYTES, stream, a); }
    }
    const hipError_t le = hipPeekAtLastError();
    if (le != hipSuccess) fprintf(stderr, "kernel_launch: launch failed: %s\n", hipGetErrorName(le));
}
```
